# Optimizing an MI355X kernel written in HIP

```python
import math
import jax, jax.numpy as jnp
from jax import lax
import numpy as np

D_MODEL = 1024
BATCH = 4
SEQ = 8192
DEPTH = 2
DEC_BATCH = 8
DEC_SEQ = 2048
PAST_LEN = 128

D_MIX = D_MODEL
MLA_HEADS = 8
MLA_NOPE = 64
MLA_ROPE = 32
MLA_V = 64
Q_LORA = 256
KV_LORA = 128
ROPE_THETA = 10000.0
Q_BLOCK = 128
DIL_HEADS = 8
DIL_HEAD_DIM = 64
DIL_PAIRS = ((128, 1), (512, 4), (2048, 16))
D_FF = 4 * D_MODEL
NORM_EPS = 1e-6
NEG_BIG = -1e30

MLA_OUT = MLA_HEADS * MLA_V
DIL_OUT = DIL_HEADS * DIL_HEAD_DIM
DIL_QKV = DIL_HEADS * DIL_HEAD_DIM
IN_COLS = Q_LORA + KV_LORA + MLA_ROPE + 3 * DIL_QKV

kernel_name = "hybrid_mla_dilated_encoder"


def rms_norm(x, g):
    xf = x.astype(jnp.float32)
    y = xf * lax.rsqrt(jnp.mean(xf * xf, axis=-1, keepdims=True) + NORM_EPS)
    return (y * g.astype(jnp.float32)).astype(x.dtype)


def rope_tables(S, dtype):
    half = MLA_ROPE // 2
    inv_freq = ROPE_THETA ** (-jnp.arange(half, dtype=jnp.float32) / half)
    ang = jnp.arange(S, dtype=jnp.float32)[:, None] * inv_freq[None, :]
    return jnp.cos(ang).astype(dtype), jnp.sin(ang).astype(dtype)


def apply_rope(x, cos, sin):
    half = x.shape[-1] // 2
    x1, x2 = x[..., :half], x[..., half:]
    c = cos[None, :, None, :]
    s = sin[None, :, None, :]
    return jnp.concatenate([x1 * c - x2 * s, x1 * s + x2 * c], axis=-1)


def mla_attention(lat_q, lat_kv, k_rope_raw, g_q_lat, w_uq, g_kv_lat, w_ukv):
    B, S, _ = lat_q.shape
    cos, sin = rope_tables(S, lat_q.dtype)
    q = jnp.einsum('bsr,rhd->bshd', rms_norm(lat_q, g_q_lat), w_uq)
    q = jnp.concatenate([q[..., :MLA_NOPE], apply_rope(q[..., MLA_NOPE:], cos, sin)], axis=-1)
    kv = jnp.einsum('bsr,rhd->bshd', rms_norm(lat_kv, g_kv_lat), w_ukv)
    k_nope, v = kv[..., :MLA_NOPE], kv[..., MLA_NOPE:]
    k_rope = apply_rope(k_rope_raw[:, :, None, :], cos, sin)
    k = jnp.concatenate([k_nope, jnp.broadcast_to(k_rope, (B, S, MLA_HEADS, MLA_ROPE))], axis=-1)
    scale = 1.0 / math.sqrt(MLA_NOPE + MLA_ROPE)
    nq = S // Q_BLOCK
    qb = jnp.moveaxis(q.reshape(B, nq, Q_BLOCK, MLA_HEADS, MLA_NOPE + MLA_ROPE), 1, 0)

    def attend(qblk):
        s = jnp.einsum('bqhd,bkhd->bhqk', qblk, k).astype(jnp.float32) * scale
        p = jax.nn.softmax(s, axis=-1)
        return jnp.einsum('bhqk,bkhd->bqhd', p.astype(v.dtype), v)

    o = lax.map(attend, qb)
    return jnp.moveaxis(o, 0, 1).reshape(B, S, MLA_OUT)


def fold(t, d):
    B, S = t.shape[:2]
    rest = t.shape[2:]
    t = t.reshape((B, S // d, d) + rest)
    t = jnp.moveaxis(t, 2, 1)
    return t.reshape((B * d, S // d) + rest)


def unfold(t, B, d):
    L = t.shape[1]
    rest = t.shape[2:]
    t = t.reshape((B, d, L) + rest)
    t = jnp.moveaxis(t, 1, 2)
    return t.reshape((B, L * d) + rest)


def banded_attention(q, k, v, n, d, slopes):
    Bp, L, H, D = q.shape
    nb = -(-L // n)
    Lp = nb * n
    qp = jnp.pad(q, ((0, 0), (0, Lp - L), (0, 0), (0, 0))).reshape(Bp, nb, n, H, D)
    pad_k = ((0, 0), (n, Lp - L + n), (0, 0), (0, 0))
    kr = jnp.pad(k, pad_k).reshape(Bp, nb + 2, n, H, D)
    vr = jnp.pad(v, pad_k).reshape(Bp, nb + 2, n, H, D)
    kw = jnp.concatenate([kr[:, :-2], kr[:, 1:-1], kr[:, 2:]], axis=2)
    vw = jnp.concatenate([vr[:, :-2], vr[:, 1:-1], vr[:, 2:]], axis=2)
    blk = jnp.arange(nb)[:, None]
    qidx = blk * n + jnp.arange(n)[None, :]
    kidx = blk * n - n + jnp.arange(3 * n)[None, :]
    rel = jnp.abs(kidx[:, None, :] - qidx[:, :, None])
    valid = (rel <= n) & (kidx[:, None, :] >= 0) & (kidx[:, None, :] < L)
    bias = -slopes[:, None, None, None] * (d * rel).astype(jnp.float32)[None]
    bias = jnp.moveaxis(bias, 0, 1)
    s = jnp.einsum('bnqhd,bnkhd->bnhqk', qp, kw).astype(jnp.float32) / math.sqrt(D)
    s = jnp.where(valid[:, None], s + bias[None], NEG_BIG)
    m = jnp.max(s, axis=-1)
    e = jnp.exp(s - m[..., None])
    den = jnp.sum(e, axis=-1)
    o = jnp.einsum('bnhqk,bnkhd->bnqhd', e.astype(v.dtype), vw).astype(jnp.float32)
    den_t = jnp.swapaxes(den, 2, 3)
    o = (o / den_t[..., None]).reshape(Bp, Lp, H, D)[:, :L]
    m_t = jnp.swapaxes(m, 2, 3).reshape(Bp, Lp, H)[:, :L]
    den_t = den_t.reshape(Bp, Lp, H)[:, :L]
    return o, m_t, den_t


def dilated_attention(q, k, v):
    B, S, H, D = q.shape
    slopes = 2.0 ** (-8.0 * (jnp.arange(H, dtype=jnp.float32) + 1.0) / H)
    outs, maxs, dens = [], [], []
    for window, d in DIL_PAIRS:
        n = window // (2 * d)
        o, m, den = banded_attention(fold(q, d), fold(k, d), fold(v, d), n, d, slopes)
        outs.append(unfold(o, B, d))
        maxs.append(unfold(m, B, d))
        dens.append(unfold(den, B, d))
    mx = jnp.stack(maxs)
    w = jnp.stack(dens) * jnp.exp(mx - jnp.max(mx, axis=0, keepdims=True))
    out = jnp.sum(w[..., None] * jnp.stack(outs), axis=0) / jnp.sum(w, axis=0)[..., None]
    return out.astype(q.dtype).reshape(B, S, H * D)


def encoder_layer(x, g_pre_mix, w_in, g_q_lat, w_uq, g_kv_lat, w_ukv, g_out_mla, g_out_dil,
                  w_out, g_post_mix, g_pre_mlp, w_up, w_down, g_post_mlp):
    B, S, _ = x.shape
    z = rms_norm(x, g_pre_mix) @ w_in
    c0 = Q_LORA
    c1 = c0 + KV_LORA
    c2 = c1 + MLA_ROPE
    c3 = c2 + DIL_QKV
    c4 = c3 + DIL_QKV
    a = mla_attention(z[..., :c0], z[..., c0:c1], z[..., c1:c2], g_q_lat, w_uq, g_kv_lat, w_ukv)
    hd = (B, S, DIL_HEADS, DIL_HEAD_DIM)
    b = dilated_attention(z[..., c2:c3].reshape(hd), z[..., c3:c4].reshape(hd), z[..., c4:].reshape(hd))
    mix = jnp.concatenate([rms_norm(a, g_out_mla), rms_norm(b, g_out_dil)], axis=-1) @ w_out
    x = x + rms_norm(mix, g_post_mix)
    u = jnp.square(jax.nn.relu(rms_norm(x, g_pre_mlp) @ w_up))
    return x + rms_norm(u @ w_down, g_post_mlp)


def setup_inputs(seed: int = 0) -> dict:
    key = jax.random.key(seed)
    ks = jax.random.split(key, 20)
    f32 = jnp.float32

    def nrm(k, shape, fan_in):
        return jax.random.normal(k, shape, f32) * (fan_in ** -0.5)

    def gain(k, dim):
        return 1.0 + 0.05 * jax.random.normal(k, (DEPTH, dim), f32)

    return {
        "x_prompt": jax.random.normal(ks[0], (BATCH, SEQ, D_MODEL), f32),
        "x_sample": jax.random.normal(ks[1], (DEC_BATCH, DEC_SEQ, D_MODEL), f32),
        "g_pre_mix": gain(ks[2], D_MODEL),
        "w_in": nrm(ks[3], (DEPTH, D_MODEL, IN_COLS), D_MODEL),
        "g_q_lat": gain(ks[4], Q_LORA),
        "w_uq": nrm(ks[5], (DEPTH, Q_LORA, MLA_HEADS, MLA_NOPE + MLA_ROPE), Q_LORA),
        "g_kv_lat": gain(ks[6], KV_LORA),
        "w_ukv": nrm(ks[7], (DEPTH, KV_LORA, MLA_HEADS, MLA_NOPE + MLA_V), KV_LORA),
        "g_out_mla": gain(ks[8], MLA_OUT),
        "g_out_dil": gain(ks[9], DIL_OUT),
        "w_out": nrm(ks[10], (DEPTH, D_MIX, D_MODEL), D_MIX),
        "g_post_mix": gain(ks[11], D_MODEL),
        "g_pre_mlp": gain(ks[12], D_MODEL),
        "w_up": nrm(ks[13], (DEPTH, D_MODEL, D_FF), D_MODEL),
        "w_down": nrm(ks[14], (DEPTH, D_FF, D_MODEL), D_FF),
        "g_post_mlp": gain(ks[15], D_MODEL),
    }


def reference(x_prompt, x_sample, g_pre_mix, w_in, g_q_lat, w_uq, g_kv_lat, w_ukv, g_out_mla,
              g_out_dil, w_out, g_post_mix, g_pre_mlp, w_up, w_down, g_post_mlp):
    def trunk(x):
        for l in range(DEPTH):
            x = encoder_layer(x, g_pre_mix[l], w_in[l], g_q_lat[l], w_uq[l], g_kv_lat[l], w_ukv[l],
                              g_out_mla[l], g_out_dil[l], w_out[l], g_post_mix[l], g_pre_mlp[l],
                              w_up[l], w_down[l], g_post_mlp[l])
        return x

    y_prompt = trunk(x_prompt)
    y_sample = trunk(x_sample)
    return (y_prompt, y_sample)
```

```cpp
#include <hip/hip_runtime.h>
#include <hip/hip_cooperative_groups.h>
#include <cstdio>
#include <cstdint>
namespace cg = cooperative_groups;

#ifndef MK_MULTI
#define MK_MULTI 0
#endif

typedef unsigned short bf16_t;
typedef short bf16x8 __attribute__((ext_vector_type(8)));
typedef short s16x4 __attribute__((ext_vector_type(4)));
typedef float f32x4 __attribute__((ext_vector_type(4)));
typedef float f32x2 __attribute__((ext_vector_type(2)));
typedef float f32x16 __attribute__((ext_vector_type(16)));
typedef unsigned u32x4 __attribute__((ext_vector_type(4)));
#define LAS __attribute__((address_space(3)))

constexpr int MTOK = 49152, MPROMPT = 32768, DM = 1024, DEPTH = 2, DFF = 4096;
constexpr int NTHREADS = 512;
constexpr int LDS_BYTES = 144 * 1024;
constexpr float EPS = 1e-6f;
constexpr float LOG2E = 1.4426950408889634f;

constexpr size_t WS_WIN = 0;
constexpr size_t WS_WUQ = WS_WIN + (size_t)2048 * 1024 * 2;
constexpr size_t WS_WUKV = WS_WUQ + (size_t)768 * 256 * 2;
constexpr size_t WS_WOUT = WS_WUKV + (size_t)1024 * 128 * 2;
constexpr size_t WS_WUP = WS_WOUT + (size_t)1024 * 1024 * 2;
constexpr size_t WS_WDN = WS_WUP + (size_t)4096 * 1024 * 2;
constexpr size_t WS_COS = WS_WDN + (size_t)4096 * 1024 * 2;
constexpr size_t WS_SIN = WS_COS + (size_t)8192 * 16 * 4;
constexpr size_t WS_H = WS_SIN + (size_t)8192 * 16 * 4;
constexpr size_t WS_U = WS_H + (size_t)MTOK * 1024 * 2;
constexpr size_t WS_BAR = WS_U + (size_t)MTOK * 4096 * 2;
constexpr size_t WS_END = WS_BAR + 256;
constexpr size_t U_ZD = 0;
constexpr size_t U_Q = 0;
constexpr size_t U_KV = U_Q + (size_t)MTOK * 768 * 2;
constexpr size_t U_LAT = U_ZD + (size_t)MTOK * 1536 * 2;
constexpr size_t U_OB = U_LAT + (size_t)MTOK * 512 * 2;
constexpr size_t U_MIX = U_OB;
constexpr size_t U_LQN = U_OB + (size_t)3 * MTOK * 512 * 2;
constexpr size_t U_LKVN = U_LQN + (size_t)MTOK * 256 * 2;
constexpr size_t U_KR = U_LKVN + (size_t)MTOK * 128 * 2;
constexpr size_t U_ML = U_KR + (size_t)MTOK * 32 * 2;
static_assert(U_ML + (size_t)3 * MTOK * 8 * 8 <= (size_t)MTOK * 4096 * 2, "mixer overlay exceeds U");
static_assert(U_KV + (size_t)MTOK * 1024 * 2 <= U_OB, "KV overlay");

struct Params {
    const float* in[16];
    float* out;
    unsigned char* ws;
    int ph_lo, ph_hi;
};

__device__ __forceinline__ int phase_tid(int wave) { int l; asm volatile("v_mbcnt_lo_u32_b32 %0, -1, 0\n\tv_mbcnt_hi_u32_b32 %0, -1, %0" : "=v"(l)); return wave * 64 + l; }
__device__ __forceinline__ unsigned cvtpk(float lo, float hi) { unsigned r; asm("v_cvt_pk_bf16_f32 %0, %1, %2" : "=v"(r) : "v"(lo), "v"(hi)); return r; }
__device__ __forceinline__ float bf2f(unsigned short b) { return __uint_as_float(((unsigned)b) << 16); }
__device__ __forceinline__ float bflo(unsigned w) { return __uint_as_float(w << 16); }
__device__ __forceinline__ float bfhi(unsigned w) { return __uint_as_float(w & 0xffff0000u); }
__device__ __forceinline__ float wave_sum(float v) {
#pragma unroll
    for (int o = 32; o >= 1; o >>= 1) v += __shfl_xor(v, o);
    return v;
}
__device__ __forceinline__ int tok_pos(int t) { return t < MPROMPT ? (t & 8191) : (t & 2047); }

__device__ __forceinline__ void wconv(const float* __restrict__ src, bf16_t* __restrict__ dst, int K, int Nsrc, int Ndst, int mode, char* lds, int p_tid) {
    float* tile = (float*)lds;
    const int tid = p_tid;
    const int ntn = Ndst / 64, ntk = K / 64;
    for (int tIdx = blockIdx.x; tIdx < ntn * ntk; tIdx += gridDim.x) {
        const int tn = tIdx / ntk, tk = tIdx % ntk;
        const int kr = tid >> 3, nc = (tid & 7) * 8;
        const int nd = tn * 64 + nc;
        int ns = nd;
        if (mode == 1) ns = nd < 416 ? nd : (nd < 512 ? -1 : nd - 96);
        f32x4 a = {0.f, 0.f, 0.f, 0.f}, b = {0.f, 0.f, 0.f, 0.f};
        if (ns >= 0) { const float* s = src + (size_t)(tk * 64 + kr) * Nsrc + ns; a = *(const f32x4*)s; b = *(const f32x4*)(s + 4); }
        float* t = tile + kr * 65 + nc;
        t[0] = a[0]; t[1] = a[1]; t[2] = a[2]; t[3] = a[3]; t[4] = b[0]; t[5] = b[1]; t[6] = b[2]; t[7] = b[3];
        __syncthreads();
        const int nr = tid >> 3, kc = (tid & 7) * 8;
        float v[8];
#pragma unroll
        for (int j = 0; j < 8; ++j) v[j] = tile[(kc + j) * 65 + nr];
        u32x4 w = {cvtpk(v[0], v[1]), cvtpk(v[2], v[3]), cvtpk(v[4], v[5]), cvtpk(v[6], v[7])};
        *(u32x4*)(dst + (size_t)(tn * 64 + nr) * K + tk * 64 + kc) = w;
        __syncthreads();
    }
}
__device__ __forceinline__ void convert_weights(const Params& p, int l, char* lds, int p_tid) {
    unsigned char* ws = p.ws;
    wconv(p.in[3] + (size_t)l * 1024 * 1952, (bf16_t*)(ws + WS_WIN), 1024, 1952, 2048, 1, lds, p_tid);
    wconv(p.in[5] + (size_t)l * 256 * 768, (bf16_t*)(ws + WS_WUQ), 256, 768, 768, 0, lds, p_tid);
    wconv(p.in[7] + (size_t)l * 128 * 1024, (bf16_t*)(ws + WS_WUKV), 128, 1024, 1024, 0, lds, p_tid);
    wconv(p.in[10] + (size_t)l * 1024 * 1024, (bf16_t*)(ws + WS_WOUT), 1024, 1024, 1024, 0, lds, p_tid);
    wconv(p.in[13] + (size_t)l * 1024 * 4096, (bf16_t*)(ws + WS_WUP), 1024, 4096, 4096, 0, lds, p_tid);
    wconv(p.in[14] + (size_t)l * 4096 * 1024, (bf16_t*)(ws + WS_WDN), 4096, 1024, 1024, 0, lds, p_tid);
}
__device__ __forceinline__ void rope_table(const Params& p, int p_tid) {
    float* cosT = (float*)(p.ws + WS_COS); float* sinT = (float*)(p.ws + WS_SIN);
    for (int idx = blockIdx.x * NTHREADS + p_tid; idx < 8192 * 16; idx += gridDim.x * NTHREADS) {
        const int s = idx >> 4, i = idx & 15;
        double f = 1.0;
        for (int j = 0; j < i; ++j) f *= 0.5623413251903491;
        const float invf = (float)f;
        const float ang = (float)s * invf;
        double rev = (double)ang * 0.15915494309189535;
        rev -= rint(rev);
        const float fr = (float)rev;
        cosT[idx] = __builtin_amdgcn_cosf(fr);
        sinT[idx] = __builtin_amdgcn_sinf(fr);
    }
}

constexpr int RP = 2;
__device__ __forceinline__ void rowpass(const Params& p, bool x_from_input, const bf16_t* branch, const float* g1, const float* g2, bf16_t* hdst, int p_tid, bool out_f32) {
    const int wid = p_tid >> 6, lane = p_tid & 63;
    for (int row0 = (blockIdx.x * 8 + wid) * RP; row0 < MTOK; row0 += gridDim.x * 8 * RP) {
        float v[RP][16]; float bv[RP][16];
#pragma unroll
        for (int q = 0; q < RP; ++q) {
            const int row = row0 + q;
            if (x_from_input) {
                const float* xr = (row < MPROMPT ? p.in[0] + (size_t)row * DM : p.in[1] + (size_t)(row - MPROMPT) * DM);
#pragma unroll
                for (int i = 0; i < 2; ++i) {
                    const int e0 = lane * 8 + i * 512;
                    const f32x4 a = *(const f32x4*)(xr + e0), b = *(const f32x4*)(xr + e0 + 4);
                    v[q][i * 8 + 0] = a[0]; v[q][i * 8 + 1] = a[1]; v[q][i * 8 + 2] = a[2]; v[q][i * 8 + 3] = a[3];
                    v[q][i * 8 + 4] = b[0]; v[q][i * 8 + 5] = b[1]; v[q][i * 8 + 6] = b[2]; v[q][i * 8 + 7] = b[3];
                }
            } else {
                const bf16_t* xr = (const bf16_t*)(p.out + (size_t)row * DM + 512);
#pragma unroll
                for (int i = 0; i < 2; ++i) {
                    const u32x4 w = *(const u32x4*)(xr + lane * 8 + i * 512);
#pragma unroll
                    for (int j = 0; j < 4; ++j) { v[q][i * 8 + 2 * j] = bflo(w[j]); v[q][i * 8 + 2 * j + 1] = bfhi(w[j]); }
                }
            }
            if (branch) {
#pragma unroll
                for (int i = 0; i < 2; ++i) {
                    const u32x4 w = *(const u32x4*)(branch + (size_t)row * DM + lane * 8 + i * 512);
#pragma unroll
                    for (int j = 0; j < 4; ++j) { bv[q][i * 8 + 2 * j] = bflo(w[j]); bv[q][i * 8 + 2 * j + 1] = bfhi(w[j]); }
                }
            }
        }
        f32x4 ga1[2][2], ga2[2][2];
#pragma unroll
        for (int i = 0; i < 2; ++i) {
            const int e0 = lane * 8 + i * 512;
            if (branch) { ga1[i][0] = *(const f32x4*)(g1 + e0); ga1[i][1] = *(const f32x4*)(g1 + e0 + 4); }
            if (g2) { ga2[i][0] = *(const f32x4*)(g2 + e0); ga2[i][1] = *(const f32x4*)(g2 + e0 + 4); }
        }
#pragma unroll
        for (int q = 0; q < RP; ++q) {
            const int row = row0 + q;
            if (branch) {
                float ss = 0.f;
#pragma unroll
                for (int j = 0; j < 16; ++j) ss += bv[q][j] * bv[q][j];
                ss = wave_sum(ss);
                const float r = rsqrtf(ss * (1.0f / 1024.0f) + EPS);
#pragma unroll
                for (int i = 0; i < 2; ++i) {
                    const int e0 = lane * 8 + i * 512;
#pragma unroll
                    for (int j = 0; j < 4; ++j) { v[q][i * 8 + j] += bv[q][i * 8 + j] * r * ga1[i][0][j]; v[q][i * 8 + 4 + j] += bv[q][i * 8 + 4 + j] * r * ga1[i][1][j]; }
                    if (out_f32) {
                        float* o = p.out + (size_t)row * DM + e0;
                        *(f32x4*)o = (f32x4){v[q][i * 8 + 0], v[q][i * 8 + 1], v[q][i * 8 + 2], v[q][i * 8 + 3]};
                        *(f32x4*)(o + 4) = (f32x4){v[q][i * 8 + 4], v[q][i * 8 + 5], v[q][i * 8 + 6], v[q][i * 8 + 7]};
                    } else {
                        u32x4 wx = {cvtpk(v[q][i * 8 + 0], v[q][i * 8 + 1]), cvtpk(v[q][i * 8 + 2], v[q][i * 8 + 3]), cvtpk(v[q][i * 8 + 4], v[q][i * 8 + 5]), cvtpk(v[q][i * 8 + 6], v[q][i * 8 + 7])};
                        *(u32x4*)((bf16_t*)(p.out + (size_t)row * DM + 512) + e0) = wx;
                    }
                }
            }
            if (g2) {
                float ss = 0.f;
#pragma unroll
                for (int j = 0; j < 16; ++j) ss += v[q][j] * v[q][j];
                ss = wave_sum(ss);
                const float r = rsqrtf(ss * (1.0f / 1024.0f) + EPS);
#pragma unroll
                for (int i = 0; i < 2; ++i) {
                    const int e0 = lane * 8 + i * 512;
                    float h[8];
#pragma unroll
                    for (int j = 0; j < 4; ++j) { h[j] = v[q][i * 8 + j] * r * ga2[i][0][j]; h[4 + j] = v[q][i * 8 + 4 + j] * r * ga2[i][1][j]; }
                    u32x4 w = {cvtpk(h[0], h[1]), cvtpk(h[2], h[3]), cvtpk(h[4], h[5]), cvtpk(h[6], h[7])};
                    *(u32x4*)(hdst + (size_t)row * DM + e0) = w;
                }
            }
        }
    }
}

__device__ __forceinline__ void latent_pass(const Params& p, int l, int p_tid) {
    const int wid = p_tid >> 6, lane = p_tid & 63;
    const bf16_t* LAT = (const bf16_t*)(p.ws + WS_U + U_LAT);
    bf16_t* LQN = (bf16_t*)(p.ws + WS_U + U_LQN); bf16_t* LKVN = (bf16_t*)(p.ws + WS_U + U_LKVN); bf16_t* KR = (bf16_t*)(p.ws + WS_U + U_KR);
    const float* gq = p.in[4] + l * 256; const float* gkv = p.in[6] + l * 128;
    const float* cosT = (const float*)(p.ws + WS_COS); const float* sinT = (const float*)(p.ws + WS_SIN);
    for (int row = blockIdx.x * 8 + wid; row < MTOK; row += gridDim.x * 8) {
        const u32x4 w = *(const u32x4*)(LAT + (size_t)row * 512 + lane * 8);
        float v[8];
#pragma unroll
        for (int j = 0; j < 4; ++j) { v[2 * j] = bflo(w[j]); v[2 * j + 1] = bfhi(w[j]); }
        float ss = 0.f;
#pragma unroll
        for (int j = 0; j < 8; ++j) ss += v[j] * v[j];
        const float sq = wave_sum(lane < 32 ? ss : 0.f);
        const float skv = wave_sum((lane >= 32 && lane < 48) ? ss : 0.f);
        float other[8];
#pragma unroll
        for (int j = 0; j < 8; ++j) other[j] = __shfl_xor(v[j], 2);
        if (lane < 32) {
            const float r = rsqrtf(sq * (1.0f / 256.0f) + EPS);
            const f32x4 ga = *(const f32x4*)(gq + lane * 8), gb = *(const f32x4*)(gq + lane * 8 + 4);
            u32x4 o = {cvtpk(v[0] * r * ga[0], v[1] * r * ga[1]), cvtpk(v[2] * r * ga[2], v[3] * r * ga[3]), cvtpk(v[4] * r * gb[0], v[5] * r * gb[1]), cvtpk(v[6] * r * gb[2], v[7] * r * gb[3])};
            *(u32x4*)(LQN + (size_t)row * 256 + lane * 8) = o;
        } else if (lane < 48) {
            const int c = (lane - 32) * 8;
            const float r = rsqrtf(skv * (1.0f / 128.0f) + EPS);
            const f32x4 ga = *(const f32x4*)(gkv + c), gb = *(const f32x4*)(gkv + c + 4);
            u32x4 o = {cvtpk(v[0] * r * ga[0], v[1] * r * ga[1]), cvtpk(v[2] * r * ga[2], v[3] * r * ga[3]), cvtpk(v[4] * r * gb[0], v[5] * r * gb[1]), cvtpk(v[6] * r * gb[2], v[7] * r * gb[3])};
            *(u32x4*)(LKVN + (size_t)row * 128 + c) = o;
        } else if (lane < 52) {
            const int q = lane - 48;
            const int i0 = (q & 1) * 8;
            const int s = tok_pos(row);
            float o[8];
#pragma unroll
            for (int j = 0; j < 8; ++j) {
                const float c = cosT[s * 16 + i0 + j], sn = sinT[s * 16 + i0 + j];
                o[j] = (q < 2) ? (v[j] * c - other[j] * sn) : (other[j] * sn + v[j] * c);
            }
            u32x4 ow = {cvtpk(o[0], o[1]), cvtpk(o[2], o[3]), cvtpk(o[4], o[5]), cvtpk(o[6], o[7])};
            *(u32x4*)(KR + (size_t)row * 32 + q * 8) = ow;
        }
    }
}

__device__ __forceinline__ void combine_pass(const Params& p, int l, int p_tid) {
    const int wid = p_tid >> 6, lane = p_tid & 63;
    bf16_t* H = (bf16_t*)(p.ws + WS_H);
    const bf16_t* OB = (const bf16_t*)(p.ws + WS_U + U_OB);
    const f32x2* ML = (const f32x2*)(p.ws + WS_U + U_ML);
    const float* ga_ = p.in[8] + l * 512; const float* gd_ = p.in[9] + l * 512;
    const int c = lane * 8, hd = lane >> 3;
    const f32x4 gaa = *(const f32x4*)(ga_ + c), gab = *(const f32x4*)(ga_ + c + 4);
    const f32x4 gda = *(const f32x4*)(gd_ + c), gdb = *(const f32x4*)(gd_ + c + 4);
    for (int row0 = (blockIdx.x * 8 + wid) * RP; row0 < MTOK; row0 += gridDim.x * 8 * RP) {
        u32x4 wa[RP], wo[RP][3]; f32x2 ml[RP][3];
#pragma unroll
        for (int q = 0; q < RP; ++q) {
            const int row = row0 + q;
            wa[q] = *(const u32x4*)(H + (size_t)row * DM + c);
#pragma unroll
            for (int i = 0; i < 3; ++i) { ml[q][i] = ML[((size_t)i * MTOK + row) * 8 + hd]; wo[q][i] = *(const u32x4*)(OB + ((size_t)i * MTOK + row) * 512 + c); }
        }
#pragma unroll
        for (int q = 0; q < RP; ++q) {
            const int row = row0 + q;
            float va[8], vd[8];
#pragma unroll
            for (int j = 0; j < 4; ++j) { va[2 * j] = bflo(wa[q][j]); va[2 * j + 1] = bfhi(wa[q][j]); }
            const float mx = fmaxf(ml[q][0][0], fmaxf(ml[q][1][0], ml[q][2][0]));
            float wsum = 0.f, wgt[3];
#pragma unroll
            for (int i = 0; i < 3; ++i) { wgt[i] = ml[q][i][1] * __builtin_amdgcn_exp2f(ml[q][i][0] - mx); wsum += wgt[i]; }
            const float inv = 1.0f / wsum;
#pragma unroll
            for (int j = 0; j < 8; ++j) vd[j] = 0.f;
#pragma unroll
            for (int i = 0; i < 3; ++i) { const float f = wgt[i] * inv;
#pragma unroll
                for (int j = 0; j < 4; ++j) { vd[2 * j] += f * bflo(wo[q][i][j]); vd[2 * j + 1] += f * bfhi(wo[q][i][j]); } }
            float sa = 0.f, sd = 0.f;
#pragma unroll
            for (int j = 0; j < 8; ++j) { sa += va[j] * va[j]; sd += vd[j] * vd[j]; }
            sa = wave_sum(sa); sd = wave_sum(sd);
            const float ra = rsqrtf(sa * (1.0f / 512.0f) + EPS), rd = rsqrtf(sd * (1.0f / 512.0f) + EPS);
            u32x4 oa = {cvtpk(va[0] * ra * gaa[0], va[1] * ra * gaa[1]), cvtpk(va[2] * ra * gaa[2], va[3] * ra * gaa[3]), cvtpk(va[4] * ra * gab[0], va[5] * ra * gab[1]), cvtpk(va[6] * ra * gab[2], va[7] * ra * gab[3])};
            u32x4 od = {cvtpk(vd[0] * rd * gda[0], vd[1] * rd * gda[1]), cvtpk(vd[2] * rd * gda[2], vd[3] * rd * gda[3]), cvtpk(vd[4] * rd * gdb[0], vd[5] * rd * gdb[1]), cvtpk(vd[6] * rd * gdb[2], vd[7] * rd * gdb[3])};
            *(u32x4*)(H + (size_t)row * DM + c) = oa;
            *(u32x4*)(H + (size_t)row * DM + 512 + c) = od;
        }
    }
}

constexpr int BM = 256, BK = 64, HALF = 128, HT = HALF * BK, NXCD = 8, WGM = 8;
__device__ __forceinline__ int lds_byte(int r, int c) { const int st = (r >> 4) * 2 + (c >> 5), rr = r & 15, cc = c & 31, ob = rr * 64 + cc * 2; return st * 1024 + (ob ^ (((ob >> 9) & 1) << 5)); }
__device__ __forceinline__ void stage_rc(int b, int& R, int& C) { const int st = b / 1024, sb = b % 1024, swz = sb ^ (((sb >> 9) & 1) << 5); R = (st >> 1) * 16 + swz / 64; C = (st & 1) * 32 + (swz % 64) / 2; }
__device__ __forceinline__ int perm32(int rho) { const int n = rho >> 4, i = rho & 15; return 8 * (i >> 2) + 4 * n + (i & 3); }

enum { EPI_PLAIN = 0, EPI_Z = 1, EPI_Q = 2, EPI_RELU2 = 3, EPI_QSCALE = 4 };
constexpr float DIL_QC = 0.125f * 1.4426950408889634f;
constexpr float MLA_QC = 0.10206207261596577f * 1.4426950408889634f;
struct EpiArgs { bf16_t* o0; bf16_t* o1; int ld; const float* cosT; const float* sinT; };

template <int EPI, int LD>
__device__ __forceinline__ void gemm_epilogue(const f32x4 (&acc)[2][2][4][2], int pm, int pn, int wid_in, const EpiArgs& e) {
    const int wid_s = __builtin_amdgcn_readfirstlane(wid_in);
    const int lane_ = phase_tid(0), wr = wid_s >> 2, wc = wid_s & 3, fr = lane_ & 15, fq = lane_ >> 4;
#pragma unroll
    for (int ai = 0; ai < 2; ++ai)
#pragma unroll
        for (int m = 0; m < 4; ++m) {
            const int row = pm * BM + ai * HALF + wr * 64 + m * 16 + fr;
#pragma unroll
            for (int bj = 0; bj < 2; ++bj) {
                const int colg = pn * BM + bj * HALF + wc * 32, col = colg + 8 * fq;
                f32x4 v0 = acc[ai][bj][m][0], v1 = acc[ai][bj][m][1];
                bf16_t* dst;
                if (EPI == EPI_Z) {
                    const int cz = col - 512;
                    dst = (pn < 2) ? e.o0 + (size_t)row * 512 + col : e.o1 + ((size_t)(cz >> 6) * MTOK + row) * 64 + (cz & 63);
                } else {
                    dst = e.o0 + (size_t)row * LD + col;
                }
                if (EPI == EPI_QSCALE) { v0 = v0 * MLA_QC; v1 = v1 * MLA_QC; }
                if (EPI == EPI_Z) { if (pn == 2 || pn == 3) { v0 = v0 * DIL_QC; v1 = v1 * DIL_QC; } }
                if (EPI == EPI_RELU2) {
#pragma unroll
                    for (int j = 0; j < 4; ++j) { float a = fmaxf(v0[j], 0.f), b = fmaxf(v1[j], 0.f); v0[j] = a * a; v1[j] = b * b; }
                }
                if (EPI == EPI_Q) {
                    if (((colg >> 5) % 3) == 2) {
                        const int s = tok_pos(row), i0 = (fq & 1) * 8;
                        const f32x4 c0 = *(const f32x4*)(e.cosT + s * 16 + i0), c1 = *(const f32x4*)(e.cosT + s * 16 + i0 + 4);
                        const f32x4 s0 = *(const f32x4*)(e.sinT + s * 16 + i0), s1 = *(const f32x4*)(e.sinT + s * 16 + i0 + 4);
#pragma unroll
                        for (int j = 0; j < 4; ++j) {
                            const float p0 = __shfl_xor(v0[j], 32), p1 = __shfl_xor(v1[j], 32);
                            v0[j] = (fq < 2) ? (v0[j] * c0[j] - p0 * s0[j]) : (p0 * s0[j] + v0[j] * c0[j]);
                            v1[j] = (fq < 2) ? (v1[j] * c1[j] - p1 * s1[j]) : (p1 * s1[j] + v1[j] * c1[j]);
                        }
                    }
                }
                u32x4 w = {cvtpk(v0[0], v0[1]), cvtpk(v0[2], v0[3]), cvtpk(v1[0], v1[1]), cvtpk(v1[2], v1[3])};
                *(u32x4*)dst = w;
            }
        }
}

template <int EPI, int N, int K, int LD, bool CONT = true>
__device__ __forceinline__ void gemm_phase(const bf16_t* __restrict__ A, const bf16_t* __restrict__ Bt, const EpiArgs& e, char* lds, int p_tid) {
    constexpr int M = MTOK;
#define SA(b, h) (((b) * 2 + (h)) * 16384)
#define SB(b, h) (65536 + ((b) * 2 + (h)) * 16384)
#define STAGE_A(P, br, kt) do { const char* _g = (const char*)(A + (size_t)(br) * K + (size_t)(kt) * BK); \
        __builtin_amdgcn_global_load_lds((const unsigned*)(_g + aoff0), (LAS unsigned*)(lds_w + (P)), 16, 0, 0); \
        __builtin_amdgcn_global_load_lds((const unsigned*)(_g + aoff1), (LAS unsigned*)(lds_w + (P) + 8192), 16, 0, 0); } while (0)
#define STAGE_B(P, br, kt) do { const char* _g = (const char*)(Bt + (size_t)(br) * K + (size_t)(kt) * BK); \
        __builtin_amdgcn_global_load_lds((const unsigned*)(_g + boff0), (LAS unsigned*)(lds_w + (P)), 16, 0, 0); \
        __builtin_amdgcn_global_load_lds((const unsigned*)(_g + boff1), (LAS unsigned*)(lds_w + (P) + 8192), 16, 0, 0); } while (0)
#define LDA(dst, b, h) _Pragma("unroll") for (int m = 0; m < 4; ++m) _Pragma("unroll") for (int k = 0; k < 2; ++k) \
        dst[m][k] = *reinterpret_cast<const LAS bf16x8*>(la_base + (((b) * 2 + (h)) * 16384 + m * 2048 + k * 1024))
#define LDB(dst, b, h) _Pragma("unroll") for (int n = 0; n < 2; ++n) _Pragma("unroll") for (int k = 0; k < 2; ++k) \
        dst[n][k] = *reinterpret_cast<const LAS bf16x8*>(lb_base + (((b) * 2 + (h)) * 16384 + n * 2048 + k * 1024))
#define MMA(ai, bj, At_, Bt_) do { __builtin_amdgcn_s_setprio(1); \
        _Pragma("unroll") for (int m = 0; m < 4; ++m) _Pragma("unroll") for (int n = 0; n < 2; ++n) _Pragma("unroll") for (int k = 0; k < 2; ++k) \
            acc[ai][bj][m][n] = __builtin_amdgcn_mfma_f32_16x16x32_bf16(Bt_[n][k], At_[m][k], acc[ai][bj][m][n], 0, 0, 0); \
        __builtin_amdgcn_s_setprio(0); } while (0)
#define WAIT_V(n) asm volatile("s_waitcnt vmcnt(" #n ")" ::: "memory")
#define WAIT_L(n) asm volatile("s_waitcnt lgkmcnt(" #n ")" ::: "memory")
#define BAR __builtin_amdgcn_s_barrier()
#define SCHED __builtin_amdgcn_sched_barrier(0)
    const int tid = p_tid, wid = tid >> 6, lane = tid & 63, wr = wid >> 2, wc = wid & 3, fr = lane & 15, fq = lane >> 4;
    const int swz_ = (fr * 64 + fq * 16) ^ ((((fr * 64 + fq * 16) >> 9) & 1) << 5);
    LAS char* lds_w = (LAS char*)lds + __builtin_amdgcn_readfirstlane(wid) * 1024;
    const LAS char* la_base = (const LAS char*)lds + wr * 8192 + swz_;
    const LAS char* lb_base = (const LAS char*)lds + 65536 + wc * 4096 + swz_;
    unsigned aoff0, aoff1, boff0, boff1;
    { int R, C; stage_rc(tid * 16, R, C); aoff0 = (unsigned)(R * K + C) * 2u; boff0 = (unsigned)(((R & ~31) | perm32(R & 31)) * K + C) * 2u;
      stage_rc(tid * 16 + 8192, R, C); aoff1 = (unsigned)(R * K + C) * 2u; boff1 = (unsigned)(((R & ~31) | perm32(R & 31)) * K + C) * 2u; }
    const int nM = M / BM, nN = N / BM, nwg = nM * nN, nt = K / BK;
#define TILE_OF(LL, PM, PN) do { int wgid_ = (LL); \
        { const int q_ = nwg / NXCD, r_ = nwg % NXCD, xcd_ = wgid_ % NXCD, off_ = wgid_ / NXCD; wgid_ = (xcd_ < r_ ? xcd_ * (q_ + 1) : r_ * (q_ + 1) + (xcd_ - r_) * q_) + off_; } \
        const int nig_ = WGM * nN, gid_ = wgid_ / nig_, fm_ = gid_ * WGM, gsz_ = (nM - fm_) < WGM ? (nM - fm_) : WGM; \
        PM = fm_ + ((wgid_ % nig_) % gsz_); PN = (wgid_ % nig_) / gsz_; } while (0)
    if constexpr (CONT) {
    if ((int)blockIdx.x < nwg) {
        const int ntile = (nwg - (int)blockIdx.x + (int)gridDim.x - 1) / (int)gridDim.x;
        int pm, pn; TILE_OF((int)blockIdx.x, pm, pn);
        int brow = pm * BM, bcol = pn * BM;
        bf16x8 At[4][2], B0[2][2], B1[2][2];
        STAGE_B(SB(0, 0), bcol, 0); STAGE_A(SA(0, 0), brow, 0); STAGE_B(SB(0, 1), bcol + HALF, 0); STAGE_A(SA(0, 1), brow + HALF, 0);
        if (wr == 1) BAR;
        WAIT_V(4); BAR;
        STAGE_B(SB(1, 0), bcol, 1); STAGE_A(SA(1, 0), brow, 1); STAGE_B(SB(1, 1), bcol + HALF, 1);
        WAIT_V(6); BAR;
#pragma unroll 1
        for (int it = 0; it < ntile; ++it) {
            f32x4 acc[2][2][4][2];
#pragma unroll
            for (int a = 0; a < 2; ++a)
#pragma unroll
                for (int b = 0; b < 2; ++b)
#pragma unroll
                    for (int m = 0; m < 4; ++m)
#pragma unroll
                        for (int n = 0; n < 2; ++n) acc[a][b][m][n] = (f32x4){0.f, 0.f, 0.f, 0.f};
            const bool last_tile = (it + 1 == ntile);
            int pmn = pm, pnn = pn;
            if (!last_tile) TILE_OF((int)blockIdx.x + (it + 1) * (int)gridDim.x, pmn, pnn);
            const int brown = pmn * BM, bcoln = pnn * BM;
            const int tend = last_tile ? nt - 2 : nt;
#pragma unroll 1
            for (int t = 0; t < tend; t += 2) {
                {
                    const bool sw = (t + 2 >= nt);
                    const int br2 = sw ? brown : brow, bc2 = sw ? bcoln : bcol, t2 = sw ? 0 : t + 2;
                    LDB(B0, 0, 0); SCHED; LDA(At, 0, 0); STAGE_A(SA(1, 1), brow + HALF, t + 1);
                    WAIT_L(8); BAR; WAIT_L(0); MMA(0, 0, At, B0); BAR; SCHED;
                    LDB(B1, 0, 1); STAGE_B(SB(0, 0), bc2, t2);
                    BAR; WAIT_L(0); MMA(0, 1, At, B1); BAR;
                    LDA(At, 0, 1); STAGE_A(SA(0, 0), br2, t2);
                    BAR; WAIT_L(0); MMA(1, 0, At, B0); BAR; SCHED;
                    STAGE_B(SB(0, 1), bc2 + HALF, t2);
                    WAIT_V(6); BAR; MMA(1, 1, At, B1); BAR;
                    LDB(B0, 1, 0); SCHED; LDA(At, 1, 0); STAGE_A(SA(0, 1), br2 + HALF, t2);
                    WAIT_L(8); BAR; WAIT_L(0); MMA(0, 0, At, B0); BAR; SCHED;
                    LDB(B1, 1, 1); STAGE_B(SB(1, 0), bc2, t2 + 1);
                    BAR; WAIT_L(0); MMA(0, 1, At, B1); BAR;
                    LDA(At, 1, 1); STAGE_A(SA(1, 0), br2, t2 + 1);
                    BAR; WAIT_L(0); MMA(1, 0, At, B0); BAR; SCHED;
                    STAGE_B(SB(1, 1), bc2 + HALF, t2 + 1);
                    WAIT_V(6); BAR; MMA(1, 1, At, B1); BAR;
                }
            }
            if (last_tile) {
                {
                    { LDB(B0, 0, 0); LDA(At, 0, 0); STAGE_A(SA(1, 1), brow + HALF, nt - 1);
                      BAR; WAIT_L(0); MMA(0, 0, At, B0); BAR;
                      LDB(B1, 0, 1); BAR; WAIT_L(0); MMA(0, 1, At, B1); BAR;
                      LDA(At, 0, 1); WAIT_V(4); BAR; WAIT_L(0); MMA(1, 0, At, B0); MMA(1, 1, At, B1); BAR; }
                    { LDB(B0, 1, 0); LDA(At, 1, 0); WAIT_V(2); BAR; WAIT_L(0); MMA(0, 0, At, B0); BAR;
                      LDB(B1, 1, 1); WAIT_V(0); BAR; WAIT_L(0); MMA(0, 1, At, B1); BAR;
                      LDA(At, 1, 1); BAR; WAIT_L(0); MMA(1, 0, At, B0); MMA(1, 1, At, B1); BAR; }
                }
            }
            gemm_epilogue<EPI, LD>(acc, pm, pn, wid, e);
            pm = pmn; pn = pnn; brow = brown; bcol = bcoln;
        }
        if (wr == 0) BAR;
    }
    } else {
    if ((int)blockIdx.x < nwg) { int pm0_, pn0_; TILE_OF((int)blockIdx.x, pm0_, pn0_); const int brow = pm0_ * BM, bcol = pn0_ * BM;
        STAGE_B(SB(0, 0), bcol, 0); STAGE_A(SA(0, 0), brow, 0); STAGE_B(SB(0, 1), bcol + HALF, 0); STAGE_A(SA(0, 1), brow + HALF, 0); }
    for (int L = blockIdx.x; L < nwg; L += gridDim.x) {
        int pm, pn; TILE_OF(L, pm, pn);
        const int brow = pm * BM, bcol = pn * BM;
        f32x4 acc[2][2][4][2];
#pragma unroll
        for (int a = 0; a < 2; ++a)
#pragma unroll
            for (int b = 0; b < 2; ++b)
#pragma unroll
                for (int m = 0; m < 4; ++m)
#pragma unroll
                    for (int n = 0; n < 2; ++n) acc[a][b][m][n] = (f32x4){0.f, 0.f, 0.f, 0.f};
        bf16x8 At[4][2], B0[2][2], B1[2][2];
        if (wr == 1) BAR;
        WAIT_V(4); BAR;
        STAGE_B(SB(1, 0), bcol, 1); STAGE_A(SA(1, 0), brow, 1); STAGE_B(SB(1, 1), bcol + HALF, 1);
        WAIT_V(6); BAR;
        for (int t = 0; t < nt - 2; t += 2) {
            LDB(B0, 0, 0); SCHED; LDA(At, 0, 0); STAGE_A(SA(1, 1), brow + HALF, t + 1);
            WAIT_L(8); BAR; WAIT_L(0); MMA(0, 0, At, B0); BAR; SCHED;
            LDB(B1, 0, 1); STAGE_B(SB(0, 0), bcol, t + 2);
            BAR; WAIT_L(0); MMA(0, 1, At, B1); BAR;
            LDA(At, 0, 1); STAGE_A(SA(0, 0), brow, t + 2);
            BAR; WAIT_L(0); MMA(1, 0, At, B0); BAR; SCHED;
            STAGE_B(SB(0, 1), bcol + HALF, t + 2);
            WAIT_V(6); BAR; MMA(1, 1, At, B1); BAR;
            LDB(B0, 1, 0); SCHED; LDA(At, 1, 0); STAGE_A(SA(0, 1), brow + HALF, t + 2);
            WAIT_L(8); BAR; WAIT_L(0); MMA(0, 0, At, B0); BAR; SCHED;
            LDB(B1, 1, 1); STAGE_B(SB(1, 0), bcol, t + 3);
            BAR; WAIT_L(0); MMA(0, 1, At, B1); BAR;
            LDA(At, 1, 1); STAGE_A(SA(1, 0), brow, t + 3);
            BAR; WAIT_L(0); MMA(1, 0, At, B0); BAR; SCHED;
            STAGE_B(SB(1, 1), bcol + HALF, t + 3);
            WAIT_V(6); BAR; MMA(1, 1, At, B1); BAR;
        }
        { LDB(B0, 0, 0); LDA(At, 0, 0); STAGE_A(SA(1, 1), brow + HALF, nt - 1);
          BAR; WAIT_L(0); MMA(0, 0, At, B0); BAR;
          LDB(B1, 0, 1); BAR; WAIT_L(0); MMA(0, 1, At, B1); BAR;
          LDA(At, 0, 1); WAIT_V(4); BAR; WAIT_L(0); MMA(1, 0, At, B0); MMA(1, 1, At, B1); BAR; }
        { LDB(B0, 1, 0); LDA(At, 1, 0); WAIT_V(2); BAR; WAIT_L(0); MMA(0, 0, At, B0); BAR;
          LDB(B1, 1, 1); WAIT_V(0); BAR; WAIT_L(0); MMA(0, 1, At, B1); BAR;
          LDA(At, 1, 1); BAR; WAIT_L(0); MMA(1, 0, At, B0); MMA(1, 1, At, B1); BAR; }
        if (wr == 0) BAR;
        { const int Ln = L + (int)gridDim.x;
          if (Ln < nwg) { int pmn, pnn; TILE_OF(Ln, pmn, pnn); const int brn = pmn * BM, bcn = pnn * BM;
              STAGE_B(SB(0, 0), bcn, 0); STAGE_A(SA(0, 0), brn, 0); STAGE_B(SB(0, 1), bcn + HALF, 0); STAGE_A(SA(0, 1), brn + HALF, 0); } }
        gemm_epilogue<EPI, LD>(acc, pm, pn, wid, e);
    }
    }
#undef TILE_OF
#undef SA
#undef SB
#undef STAGE_A
#undef STAGE_B
#undef LDA
#undef LDB
#undef MMA
}

#define KSWZ(row, colB) ((row) * 256 + ((colB) ^ (((row) & 15) << 4)))
#define KSWZ64(row, colB) ((row) * 128 + ((colB) ^ ((((row) >> 1) & 7) << 4)))
#define SBAR() __builtin_amdgcn_sched_barrier(0)
__device__ __forceinline__ int crow(int r, int hi) { return (r & 3) + 8 * (r >> 2) + 4 * hi; }
__device__ __forceinline__ int v_st(int k, int c) { const int kk = (k & ~0xC) | ((k & 4) << 1) | ((k & 8) >> 1); return ((kk >> 3) * 2 + (c >> 5)) * 512 + ((kk & 7) * 32 + (c & 31)) * 2; }
__device__ __forceinline__ int v_rd_base(int lane) { return ((lane & 3) << 3) | (((lane >> 2) & 3) << 6) | (((lane >> 4) & 1) << 5) | (((lane >> 5) & 1) << 8); }
constexpr int v_rd_off(int d0, int ks, int half) { return ((ks * 2 + half) * 2 + d0) * 512; }
template <int OFF> __device__ __forceinline__ s16x4 tr_read(int vb) {
    s16x4 r; asm volatile("ds_read_b64_tr_b16 %0, %1 offset:%2" : "=&v"(r) : "v"(vb), "i"(OFF) : "memory"); return r;
}
template <int D0> __device__ __forceinline__ void pv_one(f32x16& od, int vb, bf16x8 pa0, bf16x8 pa1, bf16x8 pa2, bf16x8 pa3) {
    const s16x4 l0 = tr_read<v_rd_off(D0, 0, 0)>(vb), h0 = tr_read<v_rd_off(D0, 0, 1)>(vb), l1 = tr_read<v_rd_off(D0, 1, 0)>(vb), h1 = tr_read<v_rd_off(D0, 1, 1)>(vb);
    const s16x4 l2 = tr_read<v_rd_off(D0, 2, 0)>(vb), h2 = tr_read<v_rd_off(D0, 2, 1)>(vb), l3 = tr_read<v_rd_off(D0, 3, 0)>(vb), h3 = tr_read<v_rd_off(D0, 3, 1)>(vb);
    asm volatile("s_waitcnt lgkmcnt(0)" ::: "memory"); SBAR();
#define PK(L, H) (bf16x8){L[0], L[1], L[2], L[3], H[0], H[1], H[2], H[3]}
    od = __builtin_amdgcn_mfma_f32_32x32x16_bf16(pa0, PK(l0, h0), od, 0, 0, 0);
    od = __builtin_amdgcn_mfma_f32_32x32x16_bf16(pa1, PK(l1, h1), od, 0, 0, 0);
    od = __builtin_amdgcn_mfma_f32_32x32x16_bf16(pa2, PK(l2, h2), od, 0, 0, 0);
    od = __builtin_amdgcn_mfma_f32_32x32x16_bf16(pa3, PK(l3, h3), od, 0, 0, 0);
#undef PK
}
__device__ __forceinline__ void pv2(f32x16* o, int vb, bf16x8 pa0, bf16x8 pa1, bf16x8 pa2, bf16x8 pa3) {
    pv_one<0>(o[0], vb, pa0, pa1, pa2, pa3); pv_one<1>(o[1], vb, pa0, pa1, pa2, pa3);
}
template <int KS0> __device__ __forceinline__ void pv_half(f32x16* o, int vb, bf16x8 pa, bf16x8 pb) {
    const s16x4 l0 = tr_read<v_rd_off(0, KS0, 0)>(vb), h0 = tr_read<v_rd_off(0, KS0, 1)>(vb), l1 = tr_read<v_rd_off(0, KS0 + 1, 0)>(vb), h1 = tr_read<v_rd_off(0, KS0 + 1, 1)>(vb);
    const s16x4 m0 = tr_read<v_rd_off(1, KS0, 0)>(vb), n0 = tr_read<v_rd_off(1, KS0, 1)>(vb), m1 = tr_read<v_rd_off(1, KS0 + 1, 0)>(vb), n1 = tr_read<v_rd_off(1, KS0 + 1, 1)>(vb);
    asm volatile("s_waitcnt lgkmcnt(0)" ::: "memory"); SBAR();
#define PK(L, H) (bf16x8){L[0], L[1], L[2], L[3], H[0], H[1], H[2], H[3]}
    o[0] = __builtin_amdgcn_mfma_f32_32x32x16_bf16(pa, PK(l0, h0), o[0], 0, 0, 0);
    o[1] = __builtin_amdgcn_mfma_f32_32x32x16_bf16(pa, PK(m0, n0), o[1], 0, 0, 0);
    o[0] = __builtin_amdgcn_mfma_f32_32x32x16_bf16(pb, PK(l1, h1), o[0], 0, 0, 0);
    o[1] = __builtin_amdgcn_mfma_f32_32x32x16_bf16(pb, PK(m1, n1), o[1], 0, 0, 0);
#undef PK
}
#define PK4(P, BASE, OUT) do { unsigned a0 = cvtpk(P[BASE + 0], P[BASE + 1]), a1 = cvtpk(P[BASE + 2], P[BASE + 3]);   \
    unsigned b0 = cvtpk(P[BASE + 4], P[BASE + 5]), b1 = cvtpk(P[BASE + 6], P[BASE + 7]);                              \
    auto r0 = __builtin_amdgcn_permlane32_swap(a0, b0, false, false); auto r1 = __builtin_amdgcn_permlane32_swap(a1, b1, false, false); \
    u32x4 w_ = {r0[0], r1[0], r0[1], r1[1]}; OUT = *reinterpret_cast<bf16x8*>(&w_); } while (0)

constexpr float MLA_SCALE = 0.10206207261596577f;
constexpr float MLA_THR = 8.f;
constexpr int SHM_V = 64 * 64 * 2, SHM_K = 64 * 256;

__device__ __forceinline__ void mla_partialSM(f32x16& p0, f32x16& p1, float& m_reg, float& mn, float& alpha) {
    constexpr float C = MLA_SCALE * LOG2E;
    float pmax = p0[0];
#pragma unroll
    for (int r = 1; r < 16; ++r) pmax = fmaxf(pmax, p0[r]);
#pragma unroll
    for (int r = 0; r < 16; ++r) pmax = fmaxf(pmax, p1[r]);
    { auto rr = __builtin_amdgcn_permlane32_swap(__float_as_uint(pmax), __float_as_uint(pmax), false, false);
      pmax = fmaxf(__uint_as_float(rr[0]), __uint_as_float(rr[1])); }
    if (__builtin_expect(__all(pmax - m_reg <= MLA_THR / MLA_SCALE), 1)) { mn = m_reg; alpha = 1.f; }
    else { mn = fmaxf(m_reg, pmax); alpha = __builtin_amdgcn_exp2f((m_reg - mn) * C); m_reg = mn; }
    const float mnC = -mn * C;
#pragma unroll
    for (int r = 0; r < 16; ++r) p0[r] = fmaf(p0[r], C, mnC);
#pragma unroll
    for (int r = 0; r < 16; ++r) p1[r] = fmaf(p1[r], C, mnC);
#pragma unroll
    for (int r = 0; r < 16; ++r) p0[r] = __builtin_amdgcn_exp2f(p0[r]);
}
__device__ __forceinline__ void mla_finishSM(f32x16& p0, f32x16& p1, float alpha, float& l_reg, bf16x8& pa0, bf16x8& pa1, bf16x8& pa2, bf16x8& pa3) {
#pragma unroll
    for (int r = 0; r < 16; ++r) p1[r] = __builtin_amdgcn_exp2f(p1[r]);
    float ps = 0;
#pragma unroll
    for (int r = 0; r < 16; ++r) ps += p0[r];
#pragma unroll
    for (int r = 0; r < 16; ++r) ps += p1[r];
    { auto rr = __builtin_amdgcn_permlane32_swap(__float_as_uint(ps), __float_as_uint(ps), false, false);
      ps = __uint_as_float(rr[0]) + __uint_as_float(rr[1]); }
    l_reg = l_reg * alpha + ps;
    PK4(p0, 0, pa0); PK4(p0, 8, pa1); PK4(p1, 0, pa2); PK4(p1, 8, pa3);
}
constexpr float MLA_THR2 = 8.f;
template <bool FIRST>
__device__ __forceinline__ void mla_partialSM2(f32x16& p0, f32x16& p1, f32x16& negm, float& alpha) {
    float pmax = p0[0];
#pragma unroll
    for (int r = 1; r < 16; ++r) pmax = fmaxf(pmax, p0[r]);
#pragma unroll
    for (int r = 0; r < 16; ++r) pmax = fmaxf(pmax, p1[r]);
    { auto rr = __builtin_amdgcn_permlane32_swap(__float_as_uint(pmax), __float_as_uint(pmax), false, false);
      pmax = fmaxf(__uint_as_float(rr[0]), __uint_as_float(rr[1])); }
    alpha = 1.f;
    if (FIRST || !__builtin_expect(__all(pmax <= MLA_THR2), 1)) {
        const float delta = FIRST ? pmax : fmaxf(pmax, 0.f);
        if (!FIRST) alpha = __builtin_amdgcn_exp2f(-delta);
        const float nm = negm[0] - delta;
#pragma unroll
        for (int r = 0; r < 16; ++r) { p0[r] -= delta; p1[r] -= delta; negm[r] = nm; }
    }
#pragma unroll
    for (int r = 0; r < 16; ++r) p0[r] = __builtin_amdgcn_exp2f(p0[r]);
}
__device__ __forceinline__ void mla_qkt2(f32x16& p0, f32x16& p1, const f32x16& negm, const char* Ks, const bf16x8* qr, int r32, int hi) {
    p0 = negm; p1 = negm;
#pragma unroll
    for (int d0 = 0; d0 < 6; ++d0) { const int cb = (d0 * 16 + hi * 8) * 2;
        const bf16x8 b0 = *reinterpret_cast<const bf16x8*>(Ks + KSWZ(r32, cb));
        const bf16x8 b1 = *reinterpret_cast<const bf16x8*>(Ks + KSWZ(32 + r32, cb));
        p0 = __builtin_amdgcn_mfma_f32_32x32x16_bf16(b0, qr[d0], p0, 0, 0, 0);
        p1 = __builtin_amdgcn_mfma_f32_32x32x16_bf16(b1, qr[d0], p1, 0, 0, 0); }
}
__device__ __forceinline__ void mla_qkt(f32x16& p0, f32x16& p1, const char* Ks, const bf16x8* qr, int r32, int hi) {
    p0 = f32x16{}; p1 = f32x16{};
#pragma unroll
    for (int d0 = 0; d0 < 6; ++d0) { const int cb = (d0 * 16 + hi * 8) * 2;
        const bf16x8 b0 = *reinterpret_cast<const bf16x8*>(Ks + KSWZ(r32, cb));
        const bf16x8 b1 = *reinterpret_cast<const bf16x8*>(Ks + KSWZ(32 + r32, cb));
        p0 = __builtin_amdgcn_mfma_f32_32x32x16_bf16(b0, qr[d0], p0, 0, 0, 0);
        p1 = __builtin_amdgcn_mfma_f32_32x32x16_bf16(b1, qr[d0], p1, 0, 0, 0); }
}

__device__ __forceinline__ void mla_unit(const bf16_t* __restrict__ Qb, const bf16_t* __restrict__ Kh, const bf16_t* __restrict__ Rh, bf16_t* __restrict__ Ob, int seq, int qpos0, const float* __restrict__ cosT, const float* __restrict__ sinT, char* lds, int p_tid) {
    const int tid = p_tid, wid = tid >> 6, lane = tid & 63, r32 = lane & 31, hi = lane >> 5;
    char* V_lds = lds; char* K_lds = lds + 3 * SHM_V;
    float* wsf = (float*)(lds + 3 * SHM_V + 3 * SHM_K) + wid * 64; float* li_l = wsf; float* al_l = wsf + 32;
    bf16_t* stg = (bf16_t*)(lds + 3 * SHM_V + 3 * SHM_K + 2048) + wid * 2048;
    float l_reg = 0; f32x16 o[2] = {}; f32x16 negm = {}; bf16x8 qr[6];
    const bf16_t* Qw = Qb + (size_t)(wid * 32 + r32) * 768 + hi * 8;
#pragma unroll
    for (int d0 = 0; d0 < 6; ++d0) qr[d0] = *reinterpret_cast<const bf16x8*>(Qw + d0 * 16);
    {
        const int sq = qpos0 + wid * 32 + r32;
        const f32x4 c0 = *(const f32x4*)(cosT + sq * 16 + hi * 8), c1 = *(const f32x4*)(cosT + sq * 16 + hi * 8 + 4);
        const f32x4 s0 = *(const f32x4*)(sinT + sq * 16 + hi * 8), s1 = *(const f32x4*)(sinT + sq * 16 + hi * 8 + 4);
        float a[8], b[8];
#pragma unroll
        for (int j = 0; j < 8; ++j) { const float x1 = bf2f((unsigned short)qr[4][j]), x2 = bf2f((unsigned short)qr[5][j]);
            const float c = j < 4 ? c0[j & 3] : c1[j & 3], s = j < 4 ? s0[j & 3] : s1[j & 3];
            a[j] = x1 * c - x2 * s; b[j] = x1 * s + x2 * c; }
        u32x4 wa = {cvtpk(a[0], a[1]), cvtpk(a[2], a[3]), cvtpk(a[4], a[5]), cvtpk(a[6], a[7])};
        u32x4 wb = {cvtpk(b[0], b[1]), cvtpk(b[2], b[3]), cvtpk(b[4], b[5]), cvtpk(b[6], b[7])};
        qr[4] = *reinterpret_cast<bf16x8*>(&wa); qr[5] = *reinterpret_cast<bf16x8*>(&wb);
    }
    const int skey = tid >> 3, sc = (tid & 7) * 8;
    const int rkey = (tid & 255) >> 2, rc = (tid & 3) * 8;
    const int vst = v_st(skey, sc), kst = KSWZ(skey, sc * 2), rst = KSWZ(rkey, (64 + rc) * 2);
    const int vb0 = (int)(uintptr_t)V_lds + v_rd_base(lane);
    struct { bf16x8 v, k, r; } sr_[1];
#define SLOAD(i, k0) do { const bf16_t* kp_ = Kh + (size_t)((k0) + skey) * 1024 + sc; sr_[i].v = *reinterpret_cast<const bf16x8*>(kp_ + 64); \
        sr_[i].k = *reinterpret_cast<const bf16x8*>(kp_); sr_[i].r = *reinterpret_cast<const bf16x8*>(Rh + (size_t)((k0) + rkey) * 32 + rc); } while (0)
#define SWRITE(b, i) do { *(bf16x8*)(V_lds + (b) * SHM_V + vst) = sr_[i].v; *(bf16x8*)(K_lds + (b) * SHM_K + kst) = sr_[i].k; \
        *(bf16x8*)(K_lds + (b) * SHM_K + rst) = sr_[i].r; } while (0)
#define SWAIT() asm volatile("s_waitcnt vmcnt(0)" ::: "memory")
#define RESC(a) do { if (__any((a) < 1.f)) { if (hi == 0) al_l[r32] = (a); asm volatile("s_waitcnt lgkmcnt(0)" ::: "memory"); \
        _Pragma("unroll") for (int d = 0; d < 2; ++d) _Pragma("unroll") for (int r = 0; r < 16; ++r) o[d][r] *= al_l[crow(r, hi)]; } } while (0)
    f32x16 pA0, pA1, pB0, pB1; float alA, alB; bf16x8 pa0, pa1, pa2, pa3; const int NT = seq / 64;
    SLOAD(0, 0);
    SWAIT(); SWRITE(0, 0); SLOAD(0, 64);
    __syncthreads();
    SWAIT(); SWRITE(1, 0); SLOAD(0, 128);
    mla_qkt2(pA0, pA1, negm, K_lds, qr, r32, hi); mla_partialSM2<true>(pA0, pA1, negm, alA);
    int sp = 0, sc_ = 1, sn = 2;
    for (int j = 1; j + 1 < NT; j += 2) {
        __syncthreads();
        SBAR(); mla_qkt2(pB0, pB1, negm, K_lds + sc_ * SHM_K, qr, r32, hi);
        mla_finishSM(pA0, pA1, alA, l_reg, pa0, pa1, pa2, pa3); SBAR();
        pv2(o, vb0 + sp * SHM_V, pa0, pa1, pa2, pa3); SBAR();
        SWAIT(); SWRITE(sn, 0); if (j + 2 < NT) SLOAD(0, (j + 2) * 64);
        mla_partialSM2<false>(pB0, pB1, negm, alB);
        RESC(alB);
        { const int t_ = sp; sp = sc_; sc_ = sn; sn = t_; }
        __syncthreads();
        SBAR(); mla_qkt2(pA0, pA1, negm, K_lds + sc_ * SHM_K, qr, r32, hi);
        mla_finishSM(pB0, pB1, alB, l_reg, pa0, pa1, pa2, pa3); SBAR();
        pv2(o, vb0 + sp * SHM_V, pa0, pa1, pa2, pa3); SBAR();
        SWAIT(); SWRITE(sn, 0); if (j + 3 < NT) SLOAD(0, (j + 3) * 64);
        mla_partialSM2<false>(pA0, pA1, negm, alA);
        RESC(alA);
        { const int t_ = sp; sp = sc_; sc_ = sn; sn = t_; }
    }
    __syncthreads();
    SBAR(); mla_qkt2(pB0, pB1, negm, K_lds + sc_ * SHM_K, qr, r32, hi);
    mla_finishSM(pA0, pA1, alA, l_reg, pa0, pa1, pa2, pa3); SBAR();
    pv2(o, vb0 + sp * SHM_V, pa0, pa1, pa2, pa3); mla_partialSM2<false>(pB0, pB1, negm, alB);
    RESC(alB);
    mla_finishSM(pB0, pB1, alB, l_reg, pa0, pa1, pa2, pa3); SBAR();
    pv2(o, vb0 + sc_ * SHM_V, pa0, pa1, pa2, pa3);
    if (hi == 0) li_l[r32] = l_reg; asm volatile("s_waitcnt lgkmcnt(0)" ::: "memory");
    float rli[16];
#pragma unroll
    for (int r = 0; r < 16; ++r) rli[r] = __builtin_amdgcn_rcpf(li_l[crow(r, hi)]);
#pragma unroll
    for (int r = 0; r < 16; r += 1) { const int orow = crow(r, hi);
#pragma unroll
        for (int d0 = 0; d0 < 2; ++d0) stg[orow * 64 + d0 * 32 + r32] = (bf16_t)(cvtpk(o[d0][r] * rli[r], 0.f) & 0xffffu); }
    asm volatile("s_waitcnt lgkmcnt(0)" ::: "memory");
    bf16_t* Ow = Ob + (size_t)(wid * 32) * 1024;
#pragma unroll
    for (int i = 0; i < 4; ++i) { const int row = i * 8 + (lane >> 3), ch = lane & 7; const u32x4 v = *(const u32x4*)(stg + row * 64 + ch * 8); *(u32x4*)(Ow + (size_t)row * 1024 + ch * 8) = v; }
    __syncthreads();
#undef SLOAD
#undef SWRITE
#undef SWAIT
}

__device__ __forceinline__ void mla_phase(const Params& p, char* lds, int p_tid) {
    const bf16_t* Q = (const bf16_t*)(p.ws + WS_U + U_Q); const bf16_t* KV = (const bf16_t*)(p.ws + WS_U + U_KV); const bf16_t* KR = (const bf16_t*)(p.ws + WS_U + U_KR);
    bf16_t* H = (bf16_t*)(p.ws + WS_H);
    for (int u = blockIdx.x; u < 1536; u += gridDim.x) {
        int tok0, qb, h, seq;
        if (u < 1024) { const int i = u >> 8, c = u & 255, bh = i * 8 + (c & 7); qb = c >> 3; h = bh & 7; tok0 = (bh >> 3) * 8192; seq = 8192; }
        else { const int u2 = u - 1024, i = u2 >> 8, c = u2 & 255, bh = (i * 8 + (c & 7)) * 4 + (c >> 6); qb = (c >> 3) & 7; h = bh & 7; tok0 = MPROMPT + (bh >> 3) * 2048; seq = 2048; }
        const int q0 = tok0 + qb * 256;
        mla_unit(Q + (size_t)q0 * 768 + h * 96, KV + (size_t)tok0 * 1024 + h * 128, KR + (size_t)tok0 * 32, H + (size_t)q0 * 1024 + h * 64, seq, qb * 256, (const float*)(p.ws + WS_COS), (const float*)(p.ws + WS_SIN), lds, p_tid);
    }
}

__device__ __forceinline__ void dil_qkt(f32x16& p0, f32x16& p1, const char* Ks, const bf16x8* qr, int r32, int hi) {
    p0 = f32x16{}; p1 = f32x16{};
#pragma unroll
    for (int d0 = 0; d0 < 4; ++d0) { const int cb = (d0 * 16 + hi * 8) * 2;
        const bf16x8 b0 = *reinterpret_cast<const bf16x8*>(Ks + KSWZ64(r32, cb));
        const bf16x8 b1 = *reinterpret_cast<const bf16x8*>(Ks + KSWZ64(32 + r32, cb));
        p0 = __builtin_amdgcn_mfma_f32_32x32x16_bf16(b0, qr[d0], p0, 0, 0, 0);
        p1 = __builtin_amdgcn_mfma_f32_32x32x16_bf16(b1, qr[d0], p1, 0, 0, 0); }
}
struct DilU { int tokbase, L, d, rr, h, br, I0; };
__device__ __forceinline__ DilU dil_decode(int u) {
    int seg, b, br, rr, qb, hd;
    if (u < 3072) { seg = 0; const int bh = u / 96; b = bh >> 3; hd = bh & 7; const int rem = u % 96; br = rem >> 5; const int x = rem & 31;
        if (br == 0) { rr = 0; qb = x; } else if (br == 1) { rr = x & 3; qb = x >> 2; } else { rr = x & 15; qb = x >> 4; } }
    else { seg = 1; const int u2 = u - 3072; const int bh = u2 >> 5; b = bh >> 3; hd = bh & 7; const int rem = u2 & 31;
        if (rem < 8) { br = 0; rr = 0; qb = rem; } else if (rem < 16) { br = 1; rr = (rem - 8) & 3; qb = (rem - 8) >> 2; } else { br = 2; rr = rem - 16; qb = 0; } }
    DilU r; r.h = hd; r.br = br; r.rr = rr; r.I0 = qb * 256;
    r.tokbase = seg ? MPROMPT + b * 2048 : b * 8192;
    r.d = br == 0 ? 1 : (br == 1 ? 4 : 16); r.L = (seg ? 2048 : 8192) / r.d;
    return r;
}
__device__ __forceinline__ void dil_phase(const Params& p, char* lds, int p_tid) {
    const bf16_t* ZD = (const bf16_t*)(p.ws + WS_U + U_ZD);
    const int tid = p_tid, wid = tid >> 6, lane = tid & 63, r32 = lane & 31, hi = lane >> 5;
    char* K_lds = lds; char* V_lds = lds + 6 * 8192;
    float* wsf = (float*)(lds + 12 * 8192) + wid * 64; float* li_l = wsf; float* al_l = wsf + 32;
    bf16_t* stg = (bf16_t*)(lds + 12 * 8192 + 2048) + wid * 2048;
    const int skey = tid >> 3, sc = (tid & 7) * 8;
    const int kst = KSWZ64(skey, sc * 2), vst = v_st(skey, sc);
    const int vb0 = (int)(uintptr_t)V_lds + v_rd_base(lane);
#define DIL_LOAD(U) bf16x8 kreg[6], vreg[6], qreg[4]; do { const int KB_ = (U).I0 - 64; \
        _Pragma("unroll") for (int T = 0; T < 6; ++T) { int kf = KB_ + 64 * T + skey; kf = kf < 0 ? 0 : (kf > (U).L - 1 ? (U).L - 1 : kf); \
            const size_t ro = (size_t)((U).tokbase + kf * (U).d + (U).rr) * 64 + sc; \
            kreg[T] = *reinterpret_cast<const bf16x8*>(ZD + (size_t)(8 + (U).h) * MTOK * 64 + ro); vreg[T] = *reinterpret_cast<const bf16x8*>(ZD + (size_t)(16 + (U).h) * MTOK * 64 + ro); } \
        { int qfc = (U).I0 + wid * 32 + r32; qfc = qfc > (U).L - 1 ? (U).L - 1 : qfc; \
          const bf16_t* qp = ZD + (size_t)(U).h * MTOK * 64 + (size_t)((U).tokbase + qfc * (U).d + (U).rr) * 64 + hi * 8; \
          _Pragma("unroll") for (int d0 = 0; d0 < 4; ++d0) qreg[d0] = *reinterpret_cast<const bf16x8*>(qp + d0 * 16); } } while (0)
    for (int u = blockIdx.x; u < 5120; u += gridDim.x) {
        const DilU cur = dil_decode(u);
        bf16x8 qr[4];
        { DIL_LOAD(cur);
#pragma unroll
          for (int T = 0; T < 6; ++T) { *(bf16x8*)(K_lds + T * 8192 + kst) = kreg[T]; *(bf16x8*)(V_lds + T * 8192 + vst) = vreg[T]; }
#pragma unroll
          for (int d0 = 0; d0 < 4; ++d0) qr[d0] = qreg[d0]; }
        __syncthreads();
        const int L = cur.L, d = cur.d, I0 = cur.I0, KB = I0 - 64, h = cur.h, rr = cur.rr, tokbase = cur.tokbase;
        bf16_t* OB = (bf16_t*)(p.ws + WS_U + U_OB) + (size_t)cur.br * MTOK * 512;
        f32x2* ML = (f32x2*)(p.ws + WS_U + U_ML) + (size_t)cur.br * MTOK * 8;
        const int qf = I0 + wid * 32 + r32;
        const bool wv = (I0 + wid * 32) < L;
        const bool edge = (KB < 0) || (KB + 384 > L);
        float m_reg = -1e30f, l_reg = 0.f; f32x16 o[2] = {};
        if (wv) {
            const float nsl = -__builtin_amdgcn_exp2f(-(float)(h + 1)) * (float)d * LOG2E;
            const float kh = (float)(4 * hi);
            const int T0 = wid >> 1;
            f32x16 P[3][2];
#pragma unroll
            for (int tt = 0; tt < 3; ++tt) { P[tt][0] = f32x16{}; P[tt][1] = f32x16{}; }
            const bool odd = (wid & 1) != 0;
#pragma unroll
            for (int d0 = 0; d0 < 4; ++d0) { const int cb = (d0 * 16 + hi * 8) * 2;
                const char* K0 = K_lds + T0 * 8192; const char* K1 = K0 + 8192; const char* K2 = K1 + 8192;
                const bf16x8 b01 = *reinterpret_cast<const bf16x8*>(K0 + KSWZ64(32 + r32, cb));
                const bf16x8 b10 = *reinterpret_cast<const bf16x8*>(K1 + KSWZ64(r32, cb)), b11 = *reinterpret_cast<const bf16x8*>(K1 + KSWZ64(32 + r32, cb));
                const bf16x8 b20 = *reinterpret_cast<const bf16x8*>(K2 + KSWZ64(r32, cb));
                P[0][1] = __builtin_amdgcn_mfma_f32_32x32x16_bf16(b01, qr[d0], P[0][1], 0, 0, 0);
                P[1][0] = __builtin_amdgcn_mfma_f32_32x32x16_bf16(b10, qr[d0], P[1][0], 0, 0, 0);
                P[1][1] = __builtin_amdgcn_mfma_f32_32x32x16_bf16(b11, qr[d0], P[1][1], 0, 0, 0);
                P[2][0] = __builtin_amdgcn_mfma_f32_32x32x16_bf16(b20, qr[d0], P[2][0], 0, 0, 0); }
            if (!odd) {
#pragma unroll
                for (int d0 = 0; d0 < 4; ++d0) { const bf16x8 b00 = *reinterpret_cast<const bf16x8*>(K_lds + T0 * 8192 + KSWZ64(r32, (d0 * 16 + hi * 8) * 2));
                    P[0][0] = __builtin_amdgcn_mfma_f32_32x32x16_bf16(b00, qr[d0], P[0][0], 0, 0, 0); }
            } else {
#pragma unroll
                for (int d0 = 0; d0 < 4; ++d0) { const bf16x8 b21 = *reinterpret_cast<const bf16x8*>(K_lds + (T0 + 2) * 8192 + KSWZ64(32 + r32, (d0 * 16 + hi * 8) * 2));
                    P[2][1] = __builtin_amdgcn_mfma_f32_32x32x16_bf16(b21, qr[d0], P[2][1], 0, 0, 0); }
            }
            float pm0 = -3.0e38f, pm1 = -3.0e38f;
#pragma unroll
            for (int tt = 0; tt < 3; ++tt) {
                const int kbase = KB + 64 * (T0 + tt);
                const float rbh = (float)(kbase - qf) + kh;
                if (!edge) {
#pragma unroll
                    for (int r = 0; r < 16; ++r) {
                        const float c_r = (float)((r & 3) + 8 * (r >> 2));
                        const float a0 = __builtin_fabsf(rbh + c_r), a1 = __builtin_fabsf(rbh + (c_r + 32.f));
                        const float s0 = fmaf(a0, nsl, P[tt][0][r]), s1 = fmaf(a1, nsl, P[tt][1][r]);
                        P[tt][0][r] = (a0 <= 64.f) ? s0 : -1e30f; P[tt][1][r] = (a1 <= 64.f) ? s1 : -1e30f;
                        pm0 = fmaxf(pm0, P[tt][0][r]); pm1 = fmaxf(pm1, P[tt][1][r]);
                    }
                } else {
                    const float klo = (float)(-kbase) - kh, khi_ = (float)(L - kbase) - kh;
#pragma unroll
                    for (int r = 0; r < 16; ++r) {
                        const float c_r = (float)((r & 3) + 8 * (r >> 2));
                        const float a0 = __builtin_fabsf(rbh + c_r), a1 = __builtin_fabsf(rbh + (c_r + 32.f));
                        const float s0 = fmaf(a0, nsl, P[tt][0][r]), s1 = fmaf(a1, nsl, P[tt][1][r]);
                        P[tt][0][r] = ((a0 <= 64.f) && (c_r >= klo) && (c_r < khi_)) ? s0 : -1e30f;
                        P[tt][1][r] = ((a1 <= 64.f) && (c_r + 32.f >= klo) && (c_r + 32.f < khi_)) ? s1 : -1e30f;
                        pm0 = fmaxf(pm0, P[tt][0][r]); pm1 = fmaxf(pm1, P[tt][1][r]);
                    }
                }
            }
            float pmax = fmaxf(pm0, pm1);
            { auto rr2 = __builtin_amdgcn_permlane32_swap(__float_as_uint(pmax), __float_as_uint(pmax), false, false);
              pmax = fmaxf(__uint_as_float(rr2[0]), __uint_as_float(rr2[1])); }
            m_reg = pmax;
            float ps0 = 0.f, ps1 = 0.f;
#pragma unroll
            for (int tt = 0; tt < 3; ++tt)
#pragma unroll
                for (int r = 0; r < 16; ++r) { P[tt][0][r] = __builtin_amdgcn_exp2f(P[tt][0][r] - pmax); P[tt][1][r] = __builtin_amdgcn_exp2f(P[tt][1][r] - pmax); ps0 += P[tt][0][r]; ps1 += P[tt][1][r]; }
            float ps = ps0 + ps1;
            { auto rr2 = __builtin_amdgcn_permlane32_swap(__float_as_uint(ps), __float_as_uint(ps), false, false);
              ps = __uint_as_float(rr2[0]) + __uint_as_float(rr2[1]); }
            l_reg = ps;
#pragma unroll
            for (int tt = 0; tt < 3; ++tt) {
                bf16x8 pa0, pa1, pa2, pa3;
                PK4(P[tt][0], 0, pa0); PK4(P[tt][0], 8, pa1); PK4(P[tt][1], 0, pa2); PK4(P[tt][1], 8, pa3);
                const int vb_ = vb0 + (T0 + tt) * 8192;
                if (tt != 0 || !odd) pv_half<0>(o, vb_, pa0, pa1);
                if (tt != 2 || odd) pv_half<2>(o, vb_, pa2, pa3);
            }
        }
        if (wv) {
            if (hi == 0) { li_l[r32] = l_reg; ML[(size_t)(tokbase + qf * d + rr) * 8 + h] = (f32x2){m_reg, l_reg}; }
            asm volatile("s_waitcnt lgkmcnt(0)" ::: "memory");
            float rli[16];
#pragma unroll
            for (int r = 0; r < 16; ++r) rli[r] = __builtin_amdgcn_rcpf(li_l[crow(r, hi)]);
#pragma unroll
            for (int r = 0; r < 16; ++r) { const int orow = crow(r, hi);
#pragma unroll
                for (int d0 = 0; d0 < 2; ++d0) stg[orow * 64 + d0 * 32 + r32] = (bf16_t)(cvtpk(o[d0][r] * rli[r], 0.f) & 0xffffu); }
            asm volatile("s_waitcnt lgkmcnt(0)" ::: "memory");
#pragma unroll
            for (int i = 0; i < 4; ++i) { const int row = i * 8 + (lane >> 3), ch = lane & 7; const u32x4 v = *(const u32x4*)(stg + row * 64 + ch * 8);
                const int qrow = I0 + wid * 32 + row;
                *(u32x4*)(OB + (size_t)(tokbase + qrow * d + rr) * 512 + h * 64 + ch * 8) = v; }
        }
        __syncthreads();
    }
#undef DIL_LOAD
}
#undef RESC


template <int L>
__device__ __forceinline__ void layer_phase(const Params& p, int s, char* lds, int wave) {
    const int p_tid = phase_tid(wave);
    unsigned char* ws = p.ws;
    bf16_t* H = (bf16_t*)(ws + WS_H); bf16_t* U = (bf16_t*)(ws + WS_U);
    EpiArgs e{}; e.cosT = (const float*)(ws + WS_COS); e.sinT = (const float*)(ws + WS_SIN);
    if (s == 0) {
        e.o0 = (bf16_t*)(ws + WS_U + U_LAT); e.o1 = (bf16_t*)(ws + WS_U + U_ZD);
        gemm_phase<EPI_Z, 2048, 1024, 0>(H, (const bf16_t*)(ws + WS_WIN), e, lds, p_tid);
    } else if (s == 1) {
        latent_pass(p, L, p_tid);
        dil_phase(p, lds, p_tid);
    } else if (s == 2) {
        e.o0 = (bf16_t*)(ws + WS_U + U_Q);
        gemm_phase<EPI_QSCALE, 768, 256, 768>((const bf16_t*)(ws + WS_U + U_LQN), (const bf16_t*)(ws + WS_WUQ), e, lds, p_tid);
        __syncthreads();
        e.o0 = (bf16_t*)(ws + WS_U + U_KV);
        gemm_phase<EPI_PLAIN, 1024, 128, 1024, false>((const bf16_t*)(ws + WS_U + U_LKVN), (const bf16_t*)(ws + WS_WUKV), e, lds, phase_tid(wave));
    } else if (s == 3) {
        mla_phase(p, lds, p_tid);
    } else if (s == 4) {
        combine_pass(p, L, p_tid);
    } else if (s == 5) {
        e.o0 = (bf16_t*)(ws + WS_U + U_MIX);
        gemm_phase<EPI_PLAIN, 1024, 1024, 1024>(H, (const bf16_t*)(ws + WS_WOUT), e, lds, p_tid);
    } else if (s == 6) {
        rowpass(p, L == 0, (const bf16_t*)(ws + WS_U + U_MIX), p.in[11] + L * 1024, p.in[12] + L * 1024, H, p_tid, false);
    } else if (s == 7) {
        e.o0 = U;
        gemm_phase<EPI_RELU2, 4096, 1024, 4096>(H, (const bf16_t*)(ws + WS_WUP), e, lds, p_tid);
    } else if (s == 8) {
        e.o0 = H;
        gemm_phase<EPI_PLAIN, 1024, 4096, 1024>(U, (const bf16_t*)(ws + WS_WDN), e, lds, p_tid);
    } else {
        if (L + 1 < DEPTH) convert_weights(p, L + 1, lds, p_tid);
        rowpass(p, false, H, p.in[15] + L * 1024, (L + 1 < DEPTH) ? p.in[2] + (L + 1) * 1024 : nullptr, H, p_tid, L + 1 == DEPTH);
    }
}

__device__ __forceinline__ void grid_barrier(unsigned* cnt, unsigned target, int p_tid) {
    asm volatile("s_waitcnt vmcnt(0) lgkmcnt(0)" ::: "memory");
    __syncthreads();
    if ((p_tid >> 6) == 0) {
        __builtin_amdgcn_fence(__ATOMIC_RELEASE, "agent");
        asm volatile("s_waitcnt vmcnt(0)" ::: "memory");
        if (p_tid == 0) {
            __hip_atomic_fetch_add(cnt, 1u, __ATOMIC_RELAXED, __HIP_MEMORY_SCOPE_AGENT);
            while (__hip_atomic_load(cnt, __ATOMIC_RELAXED, __HIP_MEMORY_SCOPE_AGENT) < target) __builtin_amdgcn_s_sleep(1);
        }
        __builtin_amdgcn_fence(__ATOMIC_ACQUIRE, "agent");
        asm volatile("s_waitcnt vmcnt(0)" ::: "memory");
    }
    __syncthreads();
}

constexpr int PH_PER_LAYER = 10;
constexpr int NPHASE = 1 + PH_PER_LAYER * DEPTH;

__global__ void __launch_bounds__(NTHREADS) fwd_megakernel(Params p) {
    extern __shared__ __attribute__((aligned(16))) char shm[];
    const int lo = p.ph_lo, hi = p.ph_hi;
    const int wave = __builtin_amdgcn_readfirstlane((int)(threadIdx.x >> 6));
    unsigned* bar_cnt = (unsigned*)(p.ws + WS_BAR);
    if (hi - lo > 1) {
        if (blockIdx.x == 0 && threadIdx.x == 0) __hip_atomic_store(bar_cnt, 0u, __ATOMIC_RELAXED, __HIP_MEMORY_SCOPE_AGENT);
        cg::this_grid().sync();
    }
    const unsigned nblk = gridDim.x;
#ifndef DUP_MASK
#define DUP_MASK 0
#endif
#define PHASE(k, body) if (lo <= (k) && (k) < hi) { body; if ((DUP_MASK >> (k)) & 1) { __syncthreads(); body; } if ((k) + 1 < hi) grid_barrier(bar_cnt, (unsigned)((k) - lo + 1) * nblk, phase_tid(wave)); }
    PHASE(0, { const int p_tid = phase_tid(wave); convert_weights(p, 0, shm, p_tid); rope_table(p, p_tid); rowpass(p, true, nullptr, nullptr, p.in[2], (bf16_t*)(p.ws + WS_H), p_tid, false); })
    PHASE(1, layer_phase<0>(p, 0, shm, wave))
    PHASE(2, layer_phase<0>(p, 1, shm, wave))
    PHASE(3, layer_phase<0>(p, 2, shm, wave))
    PHASE(4, layer_phase<0>(p, 3, shm, wave))
    PHASE(5, layer_phase<0>(p, 4, shm, wave))
    PHASE(6, layer_phase<0>(p, 5, shm, wave))
    PHASE(7, layer_phase<0>(p, 6, shm, wave))
    PHASE(8, layer_phase<0>(p, 7, shm, wave))
    PHASE(9, layer_phase<0>(p, 8, shm, wave))
    PHASE(10, layer_phase<0>(p, 9, shm, wave))
    PHASE(11, layer_phase<1>(p, 0, shm, wave))
    PHASE(12, layer_phase<1>(p, 1, shm, wave))
    PHASE(13, layer_phase<1>(p, 2, shm, wave))
    PHASE(14, layer_phase<1>(p, 3, shm, wave))
    PHASE(15, layer_phase<1>(p, 4, shm, wave))
    PHASE(16, layer_phase<1>(p, 5, shm, wave))
    PHASE(17, layer_phase<1>(p, 6, shm, wave))
    PHASE(18, layer_phase<1>(p, 7, shm, wave))
    PHASE(19, layer_phase<1>(p, 8, shm, wave))
    PHASE(20, layer_phase<1>(p, 9, shm, wave))
#undef PHASE
}

extern "C" void kernel_launch(void* const* d_in, const int* in_sizes, int n_in, void* d_out, int out_size, void* d_ws, size_t ws_size, hipStream_t stream) {
    static int grid_blocks = 0;
    if (grid_blocks == 0) {
        if (n_in != 16 || out_size != MTOK * DM || ws_size < WS_END) {
            fprintf(stderr, "kernel_launch: shape/workspace mismatch: n_in %d out %d ws %zu (need %zu)\n", n_in, out_size, ws_size, (size_t)WS_END);
            grid_blocks = -1; return;
        }
        int dev = 0, cus = 0, per_cu = 0;
        hipGetDevice(&dev);
        hipDeviceGetAttribute(&cus, hipDeviceAttributeMultiprocessorCount, dev);
        if (hipFuncSetAttribute((const void*)fwd_megakernel, hipFuncAttributeMaxDynamicSharedMemorySize, LDS_BYTES) != hipSuccess) {
            fprintf(stderr, "kernel_launch: hipFuncSetAttribute failed\n"); grid_blocks = -1; return;
        }
        hipOccupancyMaxActiveBlocksPerMultiprocessor(&per_cu, (const void*)fwd_megakernel, NTHREADS, LDS_BYTES);
        if (per_cu < 1) per_cu = 1;
        if (per_cu > 1) per_cu = 1;
        grid_blocks = cus * per_cu;
        (void)hipGetLastError();
    }
    if (grid_blocks < 0) return;
    Params p{};
    for (int i = 0; i < 16; ++i) p.in[i] = (const float*)d_in[i];
    p.out = (float*)d_out; p.ws = (unsigned char*)d_ws;
#if MK_MULTI
    for (int ph = 0; ph < NPHASE; ++ph) {
        p.ph_lo = ph; p.ph_hi = ph + 1;
        hipLaunchKernelGGL(fwd_megakernel, dim3(grid_blocks), dim3(NTHREADS), LDS_BYTES, stream, p);
    }
#else
    p.ph_lo = 0; p.ph_hi = NPHASE;
    void* args[] = {&p};
    hipError_t e = hipLaunchCooperativeKernel((const void*)fwd_megakernel, dim3(grid_blocks), dim3(NTHREADS), args, LDS_BYTES, stream);
    if (e != hipSuccess) fprintf(stderr, "cooperative launch failed: %s (grid %d)\n", hipGetErrorString(e), grid_blocks);
#endif
}
```

```cpp
#include <hip/hip_runtime.h>
#include <hip/hip_cooperative_groups.h>
#include <cstdio>
#include <cstdint>
namespace cg = cooperative_groups;

#ifndef MK_MULTI
#define MK_MULTI 0
#endif

typedef unsigned short bf16_t;
typedef short bf16x8 __attribute__((ext_vector_type(8)));
typedef short s16x4 __attribute__((ext_vector_type(4)));
typedef float f32x4 __attribute__((ext_vector_type(4)));
typedef float f32x2 __attribute__((ext_vector_type(2)));
typedef float f32x16 __attribute__((ext_vector_type(16)));
typedef unsigned u32x4 __attribute__((ext_vector_type(4)));
#define LAS __attribute__((address_space(3)))

constexpr int MTOK = 49152, MPROMPT = 32768, DM = 1024, DEPTH = 2, DFF = 4096;
constexpr int NTHREADS = 512;
constexpr int LDS_BYTES = 144 * 1024;
constexpr float EPS = 1e-6f;
constexpr float LOG2E = 1.4426950408889634f;

constexpr size_t WS_WIN = 0;
constexpr size_t WS_WUQ = WS_WIN + (size_t)2048 * 1024 * 2;
constexpr size_t WS_WUKV = WS_WUQ + (size_t)768 * 256 * 2;
constexpr size_t WS_WOUT = WS_WUKV + (size_t)1024 * 128 * 2;
constexpr size_t WS_WUP = WS_WOUT + (size_t)1024 * 1024 * 2;
constexpr size_t WS_WDN = WS_WUP + (size_t)4096 * 1024 * 2;
constexpr size_t WS_COS = WS_WDN + (size_t)4096 * 1024 * 2;
constexpr size_t WS_SIN = WS_COS + (size_t)8192 * 16 * 4;
constexpr size_t WS_H = WS_SIN + (size_t)8192 * 16 * 4;
constexpr size_t WS_U = WS_H + (size_t)MTOK * 1024 * 2;
constexpr size_t WS_BAR = WS_U + (size_t)MTOK * 4096 * 2;
constexpr size_t WS_END = WS_BAR + 256;
constexpr size_t U_ZD = 0;
constexpr size_t U_Q = 0;
constexpr size_t U_KV = U_Q + (size_t)MTOK * 768 * 2;
constexpr size_t U_LAT = U_ZD + (size_t)MTOK * 1536 * 2;
constexpr size_t U_OB = U_LAT + (size_t)MTOK * 512 * 2;
constexpr size_t U_MIX = U_OB;
constexpr size_t U_LQN = U_OB + (size_t)3 * MTOK * 512 * 2;
constexpr size_t U_LKVN = U_LQN + (size_t)MTOK * 256 * 2;
constexpr size_t U_KR = U_LKVN + (size_t)MTOK * 128 * 2;
constexpr size_t U_ML = U_KR + (size_t)MTOK * 32 * 2;
static_assert(U_ML + (size_t)3 * MTOK * 8 * 8 <= (size_t)MTOK * 4096 * 2, "mixer overlay exceeds U");
static_assert(U_KV + (size_t)MTOK * 1024 * 2 <= U_OB, "KV overlay");

struct Params {
    const float* in[16];
    float* out;
    unsigned char* ws;
    int ph_lo, ph_hi;
};

__device__ __forceinline__ int phase_tid(int wave) { int l; asm volatile("v_mbcnt_lo_u32_b32 %0, -1, 0\n\tv_mbcnt_hi_u32_b32 %0, -1, %0" : "=v"(l)); return wave * 64 + l; }
__device__ __forceinline__ unsigned cvtpk(float lo, float hi) { unsigned r; asm("v_cvt_pk_bf16_f32 %0, %1, %2" : "=v"(r) : "v"(lo), "v"(hi)); return r; }
__device__ __forceinline__ float bf2f(unsigned short b) { return __uint_as_float(((unsigned)b) << 16); }
__device__ __forceinline__ float bflo(unsigned w) { return __uint_as_float(w << 16); }
__device__ __forceinline__ float bfhi(unsigned w) { return __uint_as_float(w & 0xffff0000u); }
__device__ __forceinline__ float wave_sum(float v) {
#pragma unroll
    for (int o = 32; o >= 1; o >>= 1) v += __shfl_xor(v, o);
    return v;
}
__device__ __forceinline__ int tok_pos(int t) { return t < MPROMPT ? (t & 8191) : (t & 2047); }

__device__ __forceinline__ void wconv(const float* __restrict__ src, bf16_t* __restrict__ dst, int K, int Nsrc, int Ndst, int mode, char* lds, int p_tid) {
    float* tile = (float*)lds;
    const int tid = p_tid;
    const int ntn = Ndst / 64, ntk = K / 64;
    for (int tIdx = blockIdx.x; tIdx < ntn * ntk; tIdx += gridDim.x) {
        const int tn = tIdx / ntk, tk = tIdx % ntk;
        const int kr = tid >> 3, nc = (tid & 7) * 8;
        const int nd = tn * 64 + nc;
        int ns = nd;
        if (mode == 1) ns = nd < 416 ? nd : (nd < 512 ? -1 : nd - 96);
        f32x4 a = {0.f, 0.f, 0.f, 0.f}, b = {0.f, 0.f, 0.f, 0.f};
        if (ns >= 0) { const float* s = src + (size_t)(tk * 64 + kr) * Nsrc + ns; a = *(const f32x4*)s; b = *(const f32x4*)(s + 4); }
        float* t = tile + kr * 65 + nc;
        t[0] = a[0]; t[1] = a[1]; t[2] = a[2]; t[3] = a[3]; t[4] = b[0]; t[5] = b[1]; t[6] = b[2]; t[7] = b[3];
        __syncthreads();
        const int nr = tid >> 3, kc = (tid & 7) * 8;
        float v[8];
#pragma unroll
        for (int j = 0; j < 8; ++j) v[j] = tile[(kc + j) * 65 + nr];
        u32x4 w = {cvtpk(v[0], v[1]), cvtpk(v[2], v[3]), cvtpk(v[4], v[5]), cvtpk(v[6], v[7])};
        *(u32x4*)(dst + (size_t)(tn * 64 + nr) * K + tk * 64 + kc) = w;
        __syncthreads();
    }
}
__device__ __forceinline__ void convert_weights(const Params& p, int l, char* lds, int p_tid) {
    unsigned char* ws = p.ws;
    wconv(p.in[3] + (size_t)l * 1024 * 1952, (bf16_t*)(ws + WS_WIN), 1024, 1952, 2048, 1, lds, p_tid);
    wconv(p.in[5] + (size_t)l * 256 * 768, (bf16_t*)(ws + WS_WUQ), 256, 768, 768, 0, lds, p_tid);
    wconv(p.in[7] + (size_t)l * 128 * 1024, (bf16_t*)(ws + WS_WUKV), 128, 1024, 1024, 0, lds, p_tid);
    wconv(p.in[10] + (size_t)l * 1024 * 1024, (bf16_t*)(ws + WS_WOUT), 1024, 1024, 1024, 0, lds, p_tid);
    wconv(p.in[13] + (size_t)l * 1024 * 4096, (bf16_t*)(ws + WS_WUP), 1024, 4096, 4096, 0, lds, p_tid);
    wconv(p.in[14] + (size_t)l * 4096 * 1024, (bf16_t*)(ws + WS_WDN), 4096, 1024, 1024, 0, lds, p_tid);
}
__device__ __forceinline__ void rope_table(const Params& p, int p_tid) {
    float* cosT = (float*)(p.ws + WS_COS); float* sinT = (float*)(p.ws + WS_SIN);
    for (int idx = blockIdx.x * NTHREADS + p_tid; idx < 8192 * 16; idx += gridDim.x * NTHREADS) {
        const int s = idx >> 4, i = idx & 15;
        double f = 1.0;
        for (int j = 0; j < i; ++j) f *= 0.5623413251903491;
        const float invf = (float)f;
        const float ang = (float)s * invf;
        double rev = (double)ang * 0.15915494309189535;
        rev -= rint(rev);
        const float fr = (float)rev;
        cosT[idx] = __builtin_amdgcn_cosf(fr);
        sinT[idx] = __builtin_amdgcn_sinf(fr);
    }
}

constexpr int RP = 2;
__device__ __forceinline__ void rowpass(const Params& p, bool x_from_input, const bf16_t* branch, const float* g1, const float* g2, bf16_t* hdst, int p_tid, bool out_f32) {
    const int wid = p_tid >> 6, lane = p_tid & 63;
    for (int row0 = (blockIdx.x * 8 + wid) * RP; row0 < MTOK; row0 += gridDim.x * 8 * RP) {
        float v[RP][16]; float bv[RP][16];
#pragma unroll
        for (int q = 0; q < RP; ++q) {
            const int row = row0 + q;
            if (x_from_input) {
                const float* xr = (row < MPROMPT ? p.in[0] + (size_t)row * DM : p.in[1] + (size_t)(row - MPROMPT) * DM);
#pragma unroll
                for (int i = 0; i < 2; ++i) {
                    const int e0 = lane * 8 + i * 512;
                    const f32x4 a = *(const f32x4*)(xr + e0), b = *(const f32x4*)(xr + e0 + 4);
                    v[q][i * 8 + 0] = a[0]; v[q][i * 8 + 1] = a[1]; v[q][i * 8 + 2] = a[2]; v[q][i * 8 + 3] = a[3];
                    v[q][i * 8 + 4] = b[0]; v[q][i * 8 + 5] = b[1]; v[q][i * 8 + 6] = b[2]; v[q][i * 8 + 7] = b[3];
                }
            } else {
                const bf16_t* xr = (const bf16_t*)(p.out + (size_t)row * DM + 512);
#pragma unroll
                for (int i = 0; i < 2; ++i) {
                    const u32x4 w = *(const u32x4*)(xr + lane * 8 + i * 512);
#pragma unroll
                    for (int j = 0; j < 4; ++j) { v[q][i * 8 + 2 * j] = bflo(w[j]); v[q][i * 8 + 2 * j + 1] = bfhi(w[j]); }
                }
            }
            if (branch) {
#pragma unroll
                for (int i = 0; i < 2; ++i) {
                    const u32x4 w = *(const u32x4*)(branch + (size_t)row * DM + lane * 8 + i * 512);
#pragma unroll
                    for (int j = 0; j < 4; ++j) { bv[q][i * 8 + 2 * j] = bflo(w[j]); bv[q][i * 8 + 2 * j + 1] = bfhi(w[j]); }
                }
            }
        }
        f32x4 ga1[2][2], ga2[2][2];
#pragma unroll
        for (int i = 0; i < 2; ++i) {
            const int e0 = lane * 8 + i * 512;
            if (branch) { ga1[i][0] = *(const f32x4*)(g1 + e0); ga1[i][1] = *(const f32x4*)(g1 + e0 + 4); }
            if (g2) { ga2[i][0] = *(const f32x4*)(g2 + e0); ga2[i][1] = *(const f32x4*)(g2 + e0 + 4); }
        }
#pragma unroll
        for (int q = 0; q < RP; ++q) {
            const int row = row0 + q;
            if (branch) {
                float ss = 0.f;
#pragma unroll
                for (int j = 0; j < 16; ++j) ss += bv[q][j] * bv[q][j];
                ss = wave_sum(ss);
                const float r = rsqrtf(ss * (1.0f / 1024.0f) + EPS);
#pragma unroll
                for (int i = 0; i < 2; ++i) {
                    const int e0 = lane * 8 + i * 512;
#pragma unroll
                    for (int j = 0; j < 4; ++j) { v[q][i * 8 + j] += bv[q][i * 8 + j] * r * ga1[i][0][j]; v[q][i * 8 + 4 + j] += bv[q][i * 8 + 4 + j] * r * ga1[i][1][j]; }
                    if (out_f32) {
                        float* o = p.out + (size_t)row * DM + e0;
                        *(f32x4*)o = (f32x4){v[q][i * 8 + 0], v[q][i * 8 + 1], v[q][i * 8 + 2], v[q][i * 8 + 3]};
                        *(f32x4*)(o + 4) = (f32x4){v[q][i * 8 + 4], v[q][i * 8 + 5], v[q][i * 8 + 6], v[q][i * 8 + 7]};
                    } else {
                        u32x4 wx = {cvtpk(v[q][i * 8 + 0], v[q][i * 8 + 1]), cvtpk(v[q][i * 8 + 2], v[q][i * 8 + 3]), cvtpk(v[q][i * 8 + 4], v[q][i * 8 + 5]), cvtpk(v[q][i * 8 + 6], v[q][i * 8 + 7])};
                        *(u32x4*)((bf16_t*)(p.out + (size_t)row * DM + 512) + e0) = wx;
                    }
                }
            }
            if (g2) {
                float ss = 0.f;
#pragma unroll
                for (int j = 0; j < 16; ++j) ss += v[q][j] * v[q][j];
                ss = wave_sum(ss);
                const float r = rsqrtf(ss * (1.0f / 1024.0f) + EPS);
#pragma unroll
                for (int i = 0; i < 2; ++i) {
                    const int e0 = lane * 8 + i * 512;
                    float h[8];
#pragma unroll
                    for (int j = 0; j < 4; ++j) { h[j] = v[q][i * 8 + j] * r * ga2[i][0][j]; h[4 + j] = v[q][i * 8 + 4 + j] * r * ga2[i][1][j]; }
                    u32x4 w = {cvtpk(h[0], h[1]), cvtpk(h[2], h[3]), cvtpk(h[4], h[5]), cvtpk(h[6], h[7])};
                    *(u32x4*)(hdst + (size_t)row * DM + e0) = w;
                }
            }
        }
    }
}

__device__ __forceinline__ void latent_pass(const Params& p, int l, int p_tid) {
    const int wid = p_tid >> 6, lane = p_tid & 63;
    const bf16_t* LAT = (const bf16_t*)(p.ws + WS_U + U_LAT);
    bf16_t* LQN = (bf16_t*)(p.ws + WS_U + U_LQN); bf16_t* LKVN = (bf16_t*)(p.ws + WS_U + U_LKVN); bf16_t* KR = (bf16_t*)(p.ws + WS_U + U_KR);
    const float* gq = p.in[4] + l * 256; const float* gkv = p.in[6] + l * 128;
    const float* cosT = (const float*)(p.ws + WS_COS); const float* sinT = (const float*)(p.ws + WS_SIN);
    for (int row = blockIdx.x * 8 + wid; row < MTOK; row += gridDim.x * 8) {
        const u32x4 w = *(const u32x4*)(LAT + (size_t)row * 512 + lane * 8);
        float v[8];
#pragma unroll
        for (int j = 0; j < 4; ++j) { v[2 * j] = bflo(w[j]); v[2 * j + 1] = bfhi(w[j]); }
        float ss = 0.f;
#pragma unroll
        for (int j = 0; j < 8; ++j) ss += v[j] * v[j];
        const float sq = wave_sum(lane < 32 ? ss : 0.f);
        const float skv = wave_sum((lane >= 32 && lane < 48) ? ss : 0.f);
        float other[8];
#pragma unroll
        for (int j = 0; j < 8; ++j) other[j] = __shfl_xor(v[j], 2);
        if (lane < 32) {
            const float r = rsqrtf(sq * (1.0f / 256.0f) + EPS);
            const f32x4 ga = *(const f32x4*)(gq + lane * 8), gb = *(const f32x4*)(gq + lane * 8 + 4);
            u32x4 o = {cvtpk(v[0] * r * ga[0], v[1] * r * ga[1]), cvtpk(v[2] * r * ga[2], v[3] * r * ga[3]), cvtpk(v[4] * r * gb[0], v[5] * r * gb[1]), cvtpk(v[6] * r * gb[2], v[7] * r * gb[3])};
            *(u32x4*)(LQN + (size_t)row * 256 + lane * 8) = o;
        } else if (lane < 48) {
            const int c = (lane - 32) * 8;
            const float r = rsqrtf(skv * (1.0f / 128.0f) + EPS);
            const f32x4 ga = *(const f32x4*)(gkv + c), gb = *(const f32x4*)(gkv + c + 4);
            u32x4 o = {cvtpk(v[0] * r * ga[0], v[1] * r * ga[1]), cvtpk(v[2] * r * ga[2], v[3] * r * ga[3]), cvtpk(v[4] * r * gb[0], v[5] * r * gb[1]), cvtpk(v[6] * r * gb[2], v[7] * r * gb[3])};
            *(u32x4*)(LKVN + (size_t)row * 128 + c) = o;
        } else if (lane < 52) {
            const int q = lane - 48;
            const int i0 = (q & 1) * 8;
            const int s = tok_pos(row);
            float o[8];
#pragma unroll
            for (int j = 0; j < 8; ++j) {
                const float c = cosT[s * 16 + i0 + j], sn = sinT[s * 16 + i0 + j];
                o[j] = (q < 2) ? (v[j] * c - other[j] * sn) : (other[j] * sn + v[j] * c);
            }
            u32x4 ow = {cvtpk(o[0], o[1]), cvtpk(o[2], o[3]), cvtpk(o[4], o[5]), cvtpk(o[6], o[7])};
            *(u32x4*)(KR + (size_t)row * 32 + q * 8) = ow;
        }
    }
}

__device__ __forceinline__ void combine_pass(const Params& p, int l, int p_tid) {
    const int wid = p_tid >> 6, lane = p_tid & 63;
    bf16_t* H = (bf16_t*)(p.ws + WS_H);
    const bf16_t* OB = (const bf16_t*)(p.ws + WS_U + U_OB);
    const f32x2* ML = (const f32x2*)(p.ws + WS_U + U_ML);
    const float* ga_ = p.in[8] + l * 512; const float* gd_ = p.in[9] + l * 512;
    const int c = lane * 8, hd = lane >> 3;
    const f32x4 gaa = *(const f32x4*)(ga_ + c), gab = *(const f32x4*)(ga_ + c + 4);
    const f32x4 gda = *(const f32x4*)(gd_ + c), gdb = *(const f32x4*)(gd_ + c + 4);
    for (int row0 = (blockIdx.x * 8 + wid) * RP; row0 < MTOK; row0 += gridDim.x * 8 * RP) {
        u32x4 wa[RP], wo[RP][3]; f32x2 ml[RP][3];
#pragma unroll
        for (int q = 0; q < RP; ++q) {
            const int row = row0 + q;
            wa[q] = *(const u32x4*)(H + (size_t)row * DM + c);
#pragma unroll
            for (int i = 0; i < 3; ++i) { ml[q][i] = ML[((size_t)i * MTOK + row) * 8 + hd]; wo[q][i] = *(const u32x4*)(OB + ((size_t)i * MTOK + row) * 512 + c); }
        }
#pragma unroll
        for (int q = 0; q < RP; ++q) {
            const int row = row0 + q;
            float va[8], vd[8];
#pragma unroll
            for (int j = 0; j < 4; ++j) { va[2 * j] = bflo(wa[q][j]); va[2 * j + 1] = bfhi(wa[q][j]); }
            const float mx = fmaxf(ml[q][0][0], fmaxf(ml[q][1][0], ml[q][2][0]));
            float wsum = 0.f, wgt[3];
#pragma unroll
            for (int i = 0; i < 3; ++i) { wgt[i] = ml[q][i][1] * __builtin_amdgcn_exp2f(ml[q][i][0] - mx); wsum += wgt[i]; }
            const float inv = 1.0f / wsum;
#pragma unroll
            for (int j = 0; j < 8; ++j) vd[j] = 0.f;
#pragma unroll
            for (int i = 0; i < 3; ++i) { const float f = wgt[i] * inv;
#pragma unroll
                for (int j = 0; j < 4; ++j) { vd[2 * j] += f * bflo(wo[q][i][j]); vd[2 * j + 1] += f * bfhi(wo[q][i][j]); } }
            float sa = 0.f, sd = 0.f;
#pragma unroll
            for (int j = 0; j < 8; ++j) { sa += va[j] * va[j]; sd += vd[j] * vd[j]; }
            sa = wave_sum(sa); sd = wave_sum(sd);
            const float ra = rsqrtf(sa * (1.0f / 512.0f) + EPS), rd = rsqrtf(sd * (1.0f / 512.0f) + EPS);
            u32x4 oa = {cvtpk(va[0] * ra * gaa[0], va[1] * ra * gaa[1]), cvtpk(va[2] * ra * gaa[2], va[3] * ra * gaa[3]), cvtpk(va[4] * ra * gab[0], va[5] * ra * gab[1]), cvtpk(va[6] * ra * gab[2], va[7] * ra * gab[3])};
            u32x4 od = {cvtpk(vd[0] * rd * gda[0], vd[1] * rd * gda[1]), cvtpk(vd[2] * rd * gda[2], vd[3] * rd * gda[3]), cvtpk(vd[4] * rd * gdb[0], vd[5] * rd * gdb[1]), cvtpk(vd[6] * rd * gdb[2], vd[7] * rd * gdb[3])};
            *(u32x4*)(H + (size_t)row * DM + c) = oa;
            *(u32x4*)(H + (size_t)row * DM + 512 + c) = od;
        }
    }
}

constexpr int BM = 256, BK = 64, HALF = 128, HT = HALF * BK, NXCD = 8, WGM = 8;
__device__ __forceinline__ int lds_byte(int r, int c) { const int st = (r >> 4) * 2 + (c >> 5), rr = r & 15, cc = c & 31, ob = rr * 64 + cc * 2; return st * 1024 + (ob ^ (((ob >> 9) & 1) << 5)); }
__device__ __forceinline__ void stage_rc(int b, int& R, int& C) { const int st = b / 1024, sb = b % 1024, swz = sb ^ (((sb >> 9) & 1) << 5); R = (st >> 1) * 16 + swz / 64; C = (st & 1) * 32 + (swz % 64) / 2; }
__device__ __forceinline__ int perm32(int rho) { const int n = rho >> 4, i = rho & 15; return 8 * (i >> 2) + 4 * n + (i & 3); }

enum { EPI_PLAIN = 0, EPI_Z = 1, EPI_Q = 2, EPI_RELU2 = 3, EPI_QSCALE = 4 };
constexpr float DIL_QC = 0.125f * 1.4426950408889634f;
constexpr float MLA_QC = 0.10206207261596577f * 1.4426950408889634f;
struct EpiArgs { bf16_t* o0; bf16_t* o1; int ld; const float* cosT; const float* sinT; };

template <int EPI, int LD>
__device__ __forceinline__ void gemm_epilogue(const f32x4 (&acc)[2][2][4][2], int pm, int pn, int wid_in, const EpiArgs& e) {
    const int wid_s = __builtin_amdgcn_readfirstlane(wid_in);
    const int lane_ = phase_tid(0), wr = wid_s >> 2, wc = wid_s & 3, fr = lane_ & 15, fq = lane_ >> 4;
#pragma unroll
    for (int ai = 0; ai < 2; ++ai)
#pragma unroll
        for (int m = 0; m < 4; ++m) {
            const int row = pm * BM + ai * HALF + wr * 64 + m * 16 + fr;
#pragma unroll
            for (int bj = 0; bj < 2; ++bj) {
                const int colg = pn * BM + bj * HALF + wc * 32, col = colg + 8 * fq;
                f32x4 v0 = acc[ai][bj][m][0], v1 = acc[ai][bj][m][1];
                bf16_t* dst;
                if (EPI == EPI_Z) {
                    const int cz = col - 512;
                    dst = (pn < 2) ? e.o0 + (size_t)row * 512 + col : e.o1 + ((size_t)(cz >> 6) * MTOK + row) * 64 + (cz & 63);
                } else {
                    dst = e.o0 + (size_t)row * LD + col;
                }
                if (EPI == EPI_QSCALE) { v0 = v0 * MLA_QC; v1 = v1 * MLA_QC; }
                if (EPI == EPI_Z) { if (pn == 2 || pn == 3) { v0 = v0 * DIL_QC; v1 = v1 * DIL_QC; } }
                if (EPI == EPI_RELU2) {
#pragma unroll
                    for (int j = 0; j < 4; ++j) { float a = fmaxf(v0[j], 0.f), b = fmaxf(v1[j], 0.f); v0[j] = a * a; v1[j] = b * b; }
                }
                if (EPI == EPI_Q) {
                    if (((colg >> 5) % 3) == 2) {
                        const int s = tok_pos(row), i0 = (fq & 1) * 8;
                        const f32x4 c0 = *(const f32x4*)(e.cosT + s * 16 + i0), c1 = *(const f32x4*)(e.cosT + s * 16 + i0 + 4);
                        const f32x4 s0 = *(const f32x4*)(e.sinT + s * 16 + i0), s1 = *(const f32x4*)(e.sinT + s * 16 + i0 + 4);
#pragma unroll
                        for (int j = 0; j < 4; ++j) {
                            const float p0 = __shfl_xor(v0[j], 32), p1 = __shfl_xor(v1[j], 32);
                            v0[j] = (fq < 2) ? (v0[j] * c0[j] - p0 * s0[j]) : (p0 * s0[j] + v0[j] * c0[j]);
                            v1[j] = (fq < 2) ? (v1[j] * c1[j] - p1 * s1[j]) : (p1 * s1[j] + v1[j] * c1[j]);
                        }
                    }
                }
                u32x4 w = {cvtpk(v0[0], v0[1]), cvtpk(v0[2], v0[3]), cvtpk(v1[0], v1[1]), cvtpk(v1[2], v1[3])};
                *(u32x4*)dst = w;
            }
        }
}

template <int EPI, int N, int K, int LD, bool CONT = true>
__device__ __forceinline__ void gemm_phase(const bf16_t* __restrict__ A, const bf16_t* __restrict__ Bt, const EpiArgs& e, char* lds, int p_tid) {
    constexpr int M = MTOK;
#define SA(b, h) (((b) * 2 + (h)) * 16384)
#define SB(b, h) (65536 + ((b) * 2 + (h)) * 16384)
#define STAGE_A(P, br, kt) do { const char* _g = (const char*)(A + (size_t)(br) * K + (size_t)(kt) * BK); \
        __builtin_amdgcn_global_load_lds((const unsigned*)(_g + aoff0), (LAS unsigned*)(lds_w + (P)), 16, 0, 0); \
        __builtin_amdgcn_global_load_lds((const unsigned*)(_g + aoff1), (LAS unsigned*)(lds_w + (P) + 8192), 16, 0, 0); } while (0)
#define STAGE_B(P, br, kt) do { const char* _g = (const char*)(Bt + (size_t)(br) * K + (size_t)(kt) * BK); \
        __builtin_amdgcn_global_load_lds((const unsigned*)(_g + boff0), (LAS unsigned*)(lds_w + (P)), 16, 0, 0); \
        __builtin_amdgcn_global_load_lds((const unsigned*)(_g + boff1), (LAS unsigned*)(lds_w + (P) + 8192), 16, 0, 0); } while (0)
#define LDA(dst, b, h) _Pragma("unroll") for (int m = 0; m < 4; ++m) _Pragma("unroll") for (int k = 0; k < 2; ++k) \
        dst[m][k] = *reinterpret_cast<const LAS bf16x8*>(la_base + (((b) * 2 + (h)) * 16384 + m * 2048 + k * 1024))
#define LDB(dst, b, h) _Pragma("unroll") for (int n = 0; n < 2; ++n) _Pragma("unroll") for (int k = 0; k < 2; ++k) \
        dst[n][k] = *reinterpret_cast<const LAS bf16x8*>(lb_base + (((b) * 2 + (h)) * 16384 + n * 2048 + k * 1024))
#define MMA(ai, bj, At_, Bt_) do { __builtin_amdgcn_s_setprio(1); \
        _Pragma("unroll") for (int m = 0; m < 4; ++m) _Pragma("unroll") for (int n = 0; n < 2; ++n) _Pragma("unroll") for (int k = 0; k < 2; ++k) \
            acc[ai][bj][m][n] = __builtin_amdgcn_mfma_f32_16x16x32_bf16(Bt_[n][k], At_[m][k], acc[ai][bj][m][n], 0, 0, 0); \
        __builtin_amdgcn_s_setprio(0); } while (0)
#define WAIT_V(n) asm volatile("s_waitcnt vmcnt(" #n ")" ::: "memory")
#define WAIT_L(n) asm volatile("s_waitcnt lgkmcnt(" #n ")" ::: "memory")
#define BAR __builtin_amdgcn_s_barrier()
#define SCHED __builtin_amdgcn_sched_barrier(0)
    const int tid = p_tid, wid = tid >> 6, lane = tid & 63, wr = wid >> 2, wc = wid & 3, fr = lane & 15, fq = lane >> 4;
    const int swz_ = (fr * 64 + fq * 16) ^ ((((fr * 64 + fq * 16) >> 9) & 1) << 5);
    LAS char* lds_w = (LAS char*)lds + __builtin_amdgcn_readfirstlane(wid) * 1024;
    const LAS char* la_base = (const LAS char*)lds + wr * 8192 + swz_;
    const LAS char* lb_base = (const LAS char*)lds + 65536 + wc * 4096 + swz_;
    unsigned aoff0, aoff1, boff0, boff1;
    { int R, C; stage_rc(tid * 16, R, C); aoff0 = (unsigned)(R * K + C) * 2u; boff0 = (unsigned)(((R & ~31) | perm32(R & 31)) * K + C) * 2u;
      stage_rc(tid * 16 + 8192, R, C); aoff1 = (unsigned)(R * K + C) * 2u; boff1 = (unsigned)(((R & ~31) | perm32(R & 31)) * K + C) * 2u; }
    const int nM = M / BM, nN = N / BM, nwg = nM * nN, nt = K / BK;
#define TILE_OF(LL, PM, PN) do { int wgid_ = (LL); \
        { const int q_ = nwg / NXCD, r_ = nwg % NXCD, xcd_ = wgid_ % NXCD, off_ = wgid_ / NXCD; wgid_ = (xcd_ < r_ ? xcd_ * (q_ + 1) : r_ * (q_ + 1) + (xcd_ - r_) * q_) + off_; } \
        const int nig_ = WGM * nN, gid_ = wgid_ / nig_, fm_ = gid_ * WGM, gsz_ = (nM - fm_) < WGM ? (nM - fm_) : WGM; \
        PM = fm_ + ((wgid_ % nig_) % gsz_); PN = (wgid_ % nig_) / gsz_; } while (0)
    if constexpr (CONT) {
    if ((int)blockIdx.x < nwg) {
        const int ntile = (nwg - (int)blockIdx.x + (int)gridDim.x - 1) / (int)gridDim.x;
        int pm, pn; TILE_OF((int)blockIdx.x, pm, pn);
        int brow = pm * BM, bcol = pn * BM;
        bf16x8 At[4][2], B0[2][2], B1[2][2];
        STAGE_B(SB(0, 0), bcol, 0); STAGE_A(SA(0, 0), brow, 0); STAGE_B(SB(0, 1), bcol + HALF, 0); STAGE_A(SA(0, 1), brow + HALF, 0);
        if (wr == 1) BAR;
        WAIT_V(4); BAR;
        STAGE_B(SB(1, 0), bcol, 1); STAGE_A(SA(1, 0), brow, 1); STAGE_B(SB(1, 1), bcol + HALF, 1);
        WAIT_V(6); BAR;
#pragma unroll 1
        for (int it = 0; it < ntile; ++it) {
            f32x4 acc[2][2][4][2];
#pragma unroll
            for (int a = 0; a < 2; ++a)
#pragma unroll
                for (int b = 0; b < 2; ++b)
#pragma unroll
                    for (int m = 0; m < 4; ++m)
#pragma unroll
                        for (int n = 0; n < 2; ++n) acc[a][b][m][n] = (f32x4){0.f, 0.f, 0.f, 0.f};
            const bool last_tile = (it + 1 == ntile);
            int pmn = pm, pnn = pn;
            if (!last_tile) TILE_OF((int)blockIdx.x + (it + 1) * (int)gridDim.x, pmn, pnn);
            const int brown = pmn * BM, bcoln = pnn * BM;
            const int tend = last_tile ? nt - 2 : nt;
#pragma unroll 1
            for (int t = 0; t < tend; t += 2) {
                {
                    const bool sw = (t + 2 >= nt);
                    const int br2 = sw ? brown : brow, bc2 = sw ? bcoln : bcol, t2 = sw ? 0 : t + 2;
                    LDB(B0, 0, 0); SCHED; LDA(At, 0, 0); STAGE_A(SA(1, 1), brow + HALF, t + 1);
                    WAIT_L(8); BAR; WAIT_L(0); MMA(0, 0, At, B0); BAR; SCHED;
                    LDB(B1, 0, 1); STAGE_B(SB(0, 0), bc2, t2);
                    BAR; WAIT_L(0); MMA(0, 1, At, B1); BAR;
                    LDA(At, 0, 1); STAGE_A(SA(0, 0), br2, t2);
                    BAR; WAIT_L(0); MMA(1, 0, At, B0); BAR; SCHED;
                    STAGE_B(SB(0, 1), bc2 + HALF, t2);
                    WAIT_V(6); BAR; MMA(1, 1, At, B1); BAR;
                    LDB(B0, 1, 0); SCHED; LDA(At, 1, 0); STAGE_A(SA(0, 1), br2 + HALF, t2);
                    WAIT_L(8); BAR; WAIT_L(0); MMA(0, 0, At, B0); BAR; SCHED;
                    LDB(B1, 1, 1); STAGE_B(SB(1, 0), bc2, t2 + 1);
                    BAR; WAIT_L(0); MMA(0, 1, At, B1); BAR;
                    LDA(At, 1, 1); STAGE_A(SA(1, 0), br2, t2 + 1);
                    BAR; WAIT_L(0); MMA(1, 0, At, B0); BAR; SCHED;
                    STAGE_B(SB(1, 1), bc2 + HALF, t2 + 1);
                    WAIT_V(6); BAR; MMA(1, 1, At, B1); BAR;
                }
            }
            if (last_tile) {
                {
                    { LDB(B0, 0, 0); LDA(At, 0, 0); STAGE_A(SA(1, 1), brow + HALF, nt - 1);
                      BAR; WAIT_L(0); MMA(0, 0, At, B0); BAR;
                      LDB(B1, 0, 1); BAR; WAIT_L(0); MMA(0, 1, At, B1); BAR;
                      LDA(At, 0, 1); WAIT_V(4); BAR; WAIT_L(0); MMA(1, 0, At, B0); MMA(1, 1, At, B1); BAR; }
                    { LDB(B0, 1, 0); LDA(At, 1, 0); WAIT_V(2); BAR; WAIT_L(0); MMA(0, 0, At, B0); BAR;
                      LDB(B1, 1, 1); WAIT_V(0); BAR; WAIT_L(0); MMA(0, 1, At, B1); BAR;
                      LDA(At, 1, 1); BAR; WAIT_L(0); MMA(1, 0, At, B0); MMA(1, 1, At, B1); BAR; }
                }
            }
            gemm_epilogue<EPI, LD>(acc, pm, pn, wid, e);
            pm = pmn; pn = pnn; brow = brown; bcol = bcoln;
        }
        if (wr == 0) BAR;
    }
    } else {
    if ((int)blockIdx.x < nwg) { int pm0_, pn0_; TILE_OF((int)blockIdx.x, pm0_, pn0_); const int brow = pm0_ * BM, bcol = pn0_ * BM;
        STAGE_B(SB(0, 0), bcol, 0); STAGE_A(SA(0, 0), brow, 0); STAGE_B(SB(0, 1), bcol + HALF, 0); STAGE_A(SA(0, 1), brow + HALF, 0); }
    for (int L = blockIdx.x; L < nwg; L += gridDim.x) {
        int pm, pn; TILE_OF(L, pm, pn);
        const int brow = pm * BM, bcol = pn * BM;
        f32x4 acc[2][2][4][2];
#pragma unroll
        for (int a = 0; a < 2; ++a)
#pragma unroll
            for (int b = 0; b < 2; ++b)
#pragma unroll
                for (int m = 0; m < 4; ++m)
#pragma unroll
                    for (int n = 0; n < 2; ++n) acc[a][b][m][n] = (f32x4){0.f, 0.f, 0.f, 0.f};
        bf16x8 At[4][2], B0[2][2], B1[2][2];
        if (wr == 1) BAR;
        WAIT_V(4); BAR;
        STAGE_B(SB(1, 0), bcol, 1); STAGE_A(SA(1, 0), brow, 1); STAGE_B(SB(1, 1), bcol + HALF, 1);
        WAIT_V(6); BAR;
        for (int t = 0; t < nt - 2; t += 2) {
            LDB(B0, 0, 0); SCHED; LDA(At, 0, 0); STAGE_A(SA(1, 1), brow + HALF, t + 1);
            WAIT_L(8); BAR; WAIT_L(0); MMA(0, 0, At, B0); BAR; SCHED;
            LDB(B1, 0, 1); STAGE_B(SB(0, 0), bcol, t + 2);
            BAR; WAIT_L(0); MMA(0, 1, At, B1); BAR;
            LDA(At, 0, 1); STAGE_A(SA(0, 0), brow, t + 2);
            BAR; WAIT_L(0); MMA(1, 0, At, B0); BAR; SCHED;
            STAGE_B(SB(0, 1), bcol + HALF, t + 2);
            WAIT_V(6); BAR; MMA(1, 1, At, B1); BAR;
            LDB(B0, 1, 0); SCHED; LDA(At, 1, 0); STAGE_A(SA(0, 1), brow + HALF, t + 2);
            WAIT_L(8); BAR; WAIT_L(0); MMA(0, 0, At, B0); BAR; SCHED;
            LDB(B1, 1, 1); STAGE_B(SB(1, 0), bcol, t + 3);
            BAR; WAIT_L(0); MMA(0, 1, At, B1); BAR;
            LDA(At, 1, 1); STAGE_A(SA(1, 0), brow, t + 3);
            BAR; WAIT_L(0); MMA(1, 0, At, B0); BAR; SCHED;
            STAGE_B(SB(1, 1), bcol + HALF, t + 3);
            WAIT_V(6); BAR; MMA(1, 1, At, B1); BAR;
        }
        { LDB(B0, 0, 0); LDA(At, 0, 0); STAGE_A(SA(1, 1), brow + HALF, nt - 1);
          BAR; WAIT_L(0); MMA(0, 0, At, B0); BAR;
          LDB(B1, 0, 1); BAR; WAIT_L(0); MMA(0, 1, At, B1); BAR;
          LDA(At, 0, 1); WAIT_V(4); BAR; WAIT_L(0); MMA(1, 0, At, B0); MMA(1, 1, At, B1); BAR; }
        { LDB(B0, 1, 0); LDA(At, 1, 0); WAIT_V(2); BAR; WAIT_L(0); MMA(0, 0, At, B0); BAR;
          LDB(B1, 1, 1); WAIT_V(0); BAR; WAIT_L(0); MMA(0, 1, At, B1); BAR;
          LDA(At, 1, 1); BAR; WAIT_L(0); MMA(1, 0, At, B0); MMA(1, 1, At, B1); BAR; }
        if (wr == 0) BAR;
        { const int Ln = L + (int)gridDim.x;
          if (Ln < nwg) { int pmn, pnn; TILE_OF(Ln, pmn, pnn); const int brn = pmn * BM, bcn = pnn * BM;
              STAGE_B(SB(0, 0), bcn, 0); STAGE_A(SA(0, 0), brn, 0); STAGE_B(SB(0, 1), bcn + HALF, 0); STAGE_A(SA(0, 1), brn + HALF, 0); } }
        gemm_epilogue<EPI, LD>(acc, pm, pn, wid, e);
    }
    }
#undef TILE_OF
#undef SA
#undef SB
#undef STAGE_A
#undef STAGE_B
#undef LDA
#undef LDB
#undef MMA
}

#define KSWZ(row, colB) ((row) * 256 + ((colB) ^ (((row) & 15) << 4)))
#define KSWZ64(row, colB) ((row) * 128 + ((colB) ^ ((((row) >> 1) & 7) << 4)))
#define SBAR() __builtin_amdgcn_sched_barrier(0)
__device__ __forceinline__ int crow(int r, int hi) { return (r & 3) + 8 * (r >> 2) + 4 * hi; }
__device__ __forceinline__ int v_st(int k, int c) { const int kk = (k & ~0xC) | ((k & 4) << 1) | ((k & 8) >> 1); return ((kk >> 3) * 2 + (c >> 5)) * 512 + ((kk & 7) * 32 + (c & 31)) * 2; }
__device__ __forceinline__ int v_rd_base(int lane) { return ((lane & 3) << 3) | (((lane >> 2) & 3) << 6) | (((lane >> 4) & 1) << 5) | (((lane >> 5) & 1) << 8); }
constexpr int v_rd_off(int d0, int ks, int half) { return ((ks * 2 + half) * 2 + d0) * 512; }
template <int OFF> __device__ __forceinline__ s16x4 tr_read(int vb) {
    s16x4 r; asm volatile("ds_read_b64_tr_b16 %0, %1 offset:%2" : "=&v"(r) : "v"(vb), "i"(OFF) : "memory"); return r;
}
template <int D0> __device__ __forceinline__ void pv_one(f32x16& od, int vb, bf16x8 pa0, bf16x8 pa1, bf16x8 pa2, bf16x8 pa3) {
    const s16x4 l0 = tr_read<v_rd_off(D0, 0, 0)>(vb), h0 = tr_read<v_rd_off(D0, 0, 1)>(vb), l1 = tr_read<v_rd_off(D0, 1, 0)>(vb), h1 = tr_read<v_rd_off(D0, 1, 1)>(vb);
    const s16x4 l2 = tr_read<v_rd_off(D0, 2, 0)>(vb), h2 = tr_read<v_rd_off(D0, 2, 1)>(vb), l3 = tr_read<v_rd_off(D0, 3, 0)>(vb), h3 = tr_read<v_rd_off(D0, 3, 1)>(vb);
    asm volatile("s_waitcnt lgkmcnt(0)" ::: "memory"); SBAR();
#define PK(L, H) (bf16x8){L[0], L[1], L[2], L[3], H[0], H[1], H[2], H[3]}
    od = __builtin_amdgcn_mfma_f32_32x32x16_bf16(pa0, PK(l0, h0), od, 0, 0, 0);
    od = __builtin_amdgcn_mfma_f32_32x32x16_bf16(pa1, PK(l1, h1), od, 0, 0, 0);
    od = __builtin_amdgcn_mfma_f32_32x32x16_bf16(pa2, PK(l2, h2), od, 0, 0, 0);
    od = __builtin_amdgcn_mfma_f32_32x32x16_bf16(pa3, PK(l3, h3), od, 0, 0, 0);
#undef PK
}
__device__ __forceinline__ void pv2(f32x16* o, int vb, bf16x8 pa0, bf16x8 pa1, bf16x8 pa2, bf16x8 pa3) {
    pv_one<0>(o[0], vb, pa0, pa1, pa2, pa3); pv_one<1>(o[1], vb, pa0, pa1, pa2, pa3);
}
#define PK4(P, BASE, OUT) do { unsigned a0 = cvtpk(P[BASE + 0], P[BASE + 1]), a1 = cvtpk(P[BASE + 2], P[BASE + 3]);   \
    unsigned b0 = cvtpk(P[BASE + 4], P[BASE + 5]), b1 = cvtpk(P[BASE + 6], P[BASE + 7]);                              \
    auto r0 = __builtin_amdgcn_permlane32_swap(a0, b0, false, false); auto r1 = __builtin_amdgcn_permlane32_swap(a1, b1, false, false); \
    u32x4 w_ = {r0[0], r1[0], r0[1], r1[1]}; OUT = *reinterpret_cast<bf16x8*>(&w_); } while (0)

constexpr float MLA_SCALE = 0.10206207261596577f;
constexpr float MLA_THR = 8.f;
constexpr int SHM_V = 64 * 64 * 2, SHM_K = 64 * 256;

__device__ __forceinline__ void mla_partialSM(f32x16& p0, f32x16& p1, float& m_reg, float& mn, float& alpha) {
    constexpr float C = MLA_SCALE * LOG2E;
    float pmax = p0[0];
#pragma unroll
    for (int r = 1; r < 16; ++r) pmax = fmaxf(pmax, p0[r]);
#pragma unroll
    for (int r = 0; r < 16; ++r) pmax = fmaxf(pmax, p1[r]);
    { auto rr = __builtin_amdgcn_permlane32_swap(__float_as_uint(pmax), __float_as_uint(pmax), false, false);
      pmax = fmaxf(__uint_as_float(rr[0]), __uint_as_float(rr[1])); }
    if (__builtin_expect(__all(pmax - m_reg <= MLA_THR / MLA_SCALE), 1)) { mn = m_reg; alpha = 1.f; }
    else { mn = fmaxf(m_reg, pmax); alpha = __builtin_amdgcn_exp2f((m_reg - mn) * C); m_reg = mn; }
    const float mnC = -mn * C;
#pragma unroll
    for (int r = 0; r < 16; ++r) p0[r] = fmaf(p0[r], C, mnC);
#pragma unroll
    for (int r = 0; r < 16; ++r) p1[r] = fmaf(p1[r], C, mnC);
#pragma unroll
    for (int r = 0; r < 16; ++r) p0[r] = __builtin_amdgcn_exp2f(p0[r]);
}
__device__ __forceinline__ void mla_finishSM(f32x16& p0, f32x16& p1, float alpha, float& l_reg, bf16x8& pa0, bf16x8& pa1, bf16x8& pa2, bf16x8& pa3) {
#pragma unroll
    for (int r = 0; r < 16; ++r) p1[r] = __builtin_amdgcn_exp2f(p1[r]);
    float ps = 0;
#pragma unroll
    for (int r = 0; r < 16; ++r) ps += p0[r];
#pragma unroll
    for (int r = 0; r < 16; ++r) ps += p1[r];
    { auto rr = __builtin_amdgcn_permlane32_swap(__float_as_uint(ps), __float_as_uint(ps), false, false);
      ps = __uint_as_float(rr[0]) + __uint_as_float(rr[1]); }
    l_reg = l_reg * alpha + ps;
    PK4(p0, 0, pa0); PK4(p0, 8, pa1); PK4(p1, 0, pa2); PK4(p1, 8, pa3);
}
constexpr float MLA_THR2 = 8.f;
template <bool FIRST>
__device__ __forceinline__ void mla_partialSM2(f32x16& p0, f32x16& p1, f32x16& negm, float& alpha) {
    float pmax = p0[0];
#pragma unroll
    for (int r = 1; r < 16; ++r) pmax = fmaxf(pmax, p0[r]);
#pragma unroll
    for (int r = 0; r < 16; ++r) pmax = fmaxf(pmax, p1[r]);
    { auto rr = __builtin_amdgcn_permlane32_swap(__float_as_uint(pmax), __float_as_uint(pmax), false, false);
      pmax = fmaxf(__uint_as_float(rr[0]), __uint_as_float(rr[1])); }
    alpha = 1.f;
    if (FIRST || !__builtin_expect(__all(pmax <= MLA_THR2), 1)) {
        const float delta = FIRST ? pmax : fmaxf(pmax, 0.f);
        if (!FIRST) alpha = __builtin_amdgcn_exp2f(-delta);
        const float nm = negm[0] - delta;
#pragma unroll
        for (int r = 0; r < 16; ++r) { p0[r] -= delta; p1[r] -= delta; negm[r] = nm; }
    }
#pragma unroll
    for (int r = 0; r < 16; ++r) p0[r] = __builtin_amdgcn_exp2f(p0[r]);
}
__device__ __forceinline__ void mla_qkt2(f32x16& p0, f32x16& p1, const f32x16& negm, const char* Ks, const bf16x8* qr, int r32, int hi) {
    p0 = negm; p1 = negm;
#pragma unroll
    for (int d0 = 0; d0 < 6; ++d0) { const int cb = (d0 * 16 + hi * 8) * 2;
        const bf16x8 b0 = *reinterpret_cast<const bf16x8*>(Ks + KSWZ(r32, cb));
        const bf16x8 b1 = *reinterpret_cast<const bf16x8*>(Ks + KSWZ(32 + r32, cb));
        p0 = __builtin_amdgcn_mfma_f32_32x32x16_bf16(b0, qr[d0], p0, 0, 0, 0);
        p1 = __builtin_amdgcn_mfma_f32_32x32x16_bf16(b1, qr[d0], p1, 0, 0, 0); }
}
__device__ __forceinline__ void mla_qkt(f32x16& p0, f32x16& p1, const char* Ks, const bf16x8* qr, int r32, int hi) {
    p0 = f32x16{}; p1 = f32x16{};
#pragma unroll
    for (int d0 = 0; d0 < 6; ++d0) { const int cb = (d0 * 16 + hi * 8) * 2;
        const bf16x8 b0 = *reinterpret_cast<const bf16x8*>(Ks + KSWZ(r32, cb));
        const bf16x8 b1 = *reinterpret_cast<const bf16x8*>(Ks + KSWZ(32 + r32, cb));
        p0 = __builtin_amdgcn_mfma_f32_32x32x16_bf16(b0, qr[d0], p0, 0, 0, 0);
        p1 = __builtin_amdgcn_mfma_f32_32x32x16_bf16(b1, qr[d0], p1, 0, 0, 0); }
}

__device__ __forceinline__ void mla_unit(const bf16_t* __restrict__ Qb, const bf16_t* __restrict__ Kh, const bf16_t* __restrict__ Rh, bf16_t* __restrict__ Ob, int seq, int qpos0, const float* __restrict__ cosT, const float* __restrict__ sinT, char* lds, int p_tid) {
    const int tid = p_tid, wid = tid >> 6, lane = tid & 63, r32 = lane & 31, hi = lane >> 5;
    char* V_lds = lds; char* K_lds = lds + 3 * SHM_V;
    float* wsf = (float*)(lds + 3 * SHM_V + 3 * SHM_K) + wid * 64; float* li_l = wsf; float* al_l = wsf + 32;
    bf16_t* stg = (bf16_t*)(lds + 3 * SHM_V + 3 * SHM_K + 2048) + wid * 2048;
    float l_reg = 0; f32x16 o[2] = {}; f32x16 negm = {}; bf16x8 qr[6];
    const bf16_t* Qw = Qb + (size_t)(wid * 32 + r32) * 768 + hi * 8;
#pragma unroll
    for (int d0 = 0; d0 < 6; ++d0) qr[d0] = *reinterpret_cast<const bf16x8*>(Qw + d0 * 16);
    {
        const int sq = qpos0 + wid * 32 + r32;
        const f32x4 c0 = *(const f32x4*)(cosT + sq * 16 + hi * 8), c1 = *(const f32x4*)(cosT + sq * 16 + hi * 8 + 4);
        const f32x4 s0 = *(const f32x4*)(sinT + sq * 16 + hi * 8), s1 = *(const f32x4*)(sinT + sq * 16 + hi * 8 + 4);
        float a[8], b[8];
#pragma unroll
        for (int j = 0; j < 8; ++j) { const float x1 = bf2f((unsigned short)qr[4][j]), x2 = bf2f((unsigned short)qr[5][j]);
            const float c = j < 4 ? c0[j & 3] : c1[j & 3], s = j < 4 ? s0[j & 3] : s1[j & 3];
            a[j] = x1 * c - x2 * s; b[j] = x1 * s + x2 * c; }
        u32x4 wa = {cvtpk(a[0], a[1]), cvtpk(a[2], a[3]), cvtpk(a[4], a[5]), cvtpk(a[6], a[7])};
        u32x4 wb = {cvtpk(b[0], b[1]), cvtpk(b[2], b[3]), cvtpk(b[4], b[5]), cvtpk(b[6], b[7])};
        qr[4] = *reinterpret_cast<bf16x8*>(&wa); qr[5] = *reinterpret_cast<bf16x8*>(&wb);
    }
    const int skey = tid >> 3, sc = (tid & 7) * 8;
    const int rkey = (tid & 255) >> 2, rc = (tid & 3) * 8;
    const int vst = v_st(skey, sc), kst = KSWZ(skey, sc * 2), rst = KSWZ(rkey, (64 + rc) * 2);
    const int vb0 = (int)(uintptr_t)V_lds + v_rd_base(lane);
    struct { bf16x8 v, k, r; } sr_[1];
#define SLOAD(i, k0) do { const bf16_t* kp_ = Kh + (size_t)((k0) + skey) * 1024 + sc; sr_[i].v = *reinterpret_cast<const bf16x8*>(kp_ + 64); \
        sr_[i].k = *reinterpret_cast<const bf16x8*>(kp_); sr_[i].r = *reinterpret_cast<const bf16x8*>(Rh + (size_t)((k0) + rkey) * 32 + rc); } while (0)
#define SWRITE(b, i) do { *(bf16x8*)(V_lds + (b) * SHM_V + vst) = sr_[i].v; *(bf16x8*)(K_lds + (b) * SHM_K + kst) = sr_[i].k; \
        *(bf16x8*)(K_lds + (b) * SHM_K + rst) = sr_[i].r; } while (0)
#define SWAIT() asm volatile("s_waitcnt vmcnt(0)" ::: "memory")
#define RESC(a) do { if (__any((a) < 1.f)) { if (hi == 0) al_l[r32] = (a); asm volatile("s_waitcnt lgkmcnt(0)" ::: "memory"); \
        _Pragma("unroll") for (int d = 0; d < 2; ++d) _Pragma("unroll") for (int r = 0; r < 16; ++r) o[d][r] *= al_l[crow(r, hi)]; } } while (0)
    f32x16 pA0, pA1, pB0, pB1; float alA, alB; bf16x8 pa0, pa1, pa2, pa3; const int NT = seq / 64;
    SLOAD(0, 0);
    SWAIT(); SWRITE(0, 0); SLOAD(0, 64);
    __syncthreads();
    SWAIT(); SWRITE(1, 0); SLOAD(0, 128);
    mla_qkt2(pA0, pA1, negm, K_lds, qr, r32, hi); mla_partialSM2<true>(pA0, pA1, negm, alA);
    int sp = 0, sc_ = 1, sn = 2;
    for (int j = 1; j + 1 < NT; j += 2) {
        __syncthreads();
        SBAR(); mla_qkt2(pB0, pB1, negm, K_lds + sc_ * SHM_K, qr, r32, hi);
        mla_finishSM(pA0, pA1, alA, l_reg, pa0, pa1, pa2, pa3); SBAR();
        pv_one<0>(o[0], vb0 + sp * SHM_V, pa0, pa1, pa2, pa3); SBAR();
        SWAIT(); SWRITE(sn, 0); if (j + 2 < NT) SLOAD(0, (j + 2) * 64);
        pv_one<1>(o[1], vb0 + sp * SHM_V, pa0, pa1, pa2, pa3);
        mla_partialSM2<false>(pB0, pB1, negm, alB);
        RESC(alB);
        { const int t_ = sp; sp = sc_; sc_ = sn; sn = t_; }
        __syncthreads();
        SBAR(); mla_qkt2(pA0, pA1, negm, K_lds + sc_ * SHM_K, qr, r32, hi);
        mla_finishSM(pB0, pB1, alB, l_reg, pa0, pa1, pa2, pa3); SBAR();
        pv_one<0>(o[0], vb0 + sp * SHM_V, pa0, pa1, pa2, pa3); SBAR();
        SWAIT(); SWRITE(sn, 0); if (j + 3 < NT) SLOAD(0, (j + 3) * 64);
        pv_one<1>(o[1], vb0 + sp * SHM_V, pa0, pa1, pa2, pa3);
        mla_partialSM2<false>(pA0, pA1, negm, alA);
        RESC(alA);
        { const int t_ = sp; sp = sc_; sc_ = sn; sn = t_; }
    }
    __syncthreads();
    SBAR(); mla_qkt2(pB0, pB1, negm, K_lds + sc_ * SHM_K, qr, r32, hi);
    mla_finishSM(pA0, pA1, alA, l_reg, pa0, pa1, pa2, pa3); SBAR();
    pv2(o, vb0 + sp * SHM_V, pa0, pa1, pa2, pa3); mla_partialSM2<false>(pB0, pB1, negm, alB);
    RESC(alB);
    mla_finishSM(pB0, pB1, alB, l_reg, pa0, pa1, pa2, pa3); SBAR();
    pv2(o, vb0 + sc_ * SHM_V, pa0, pa1, pa2, pa3);
    if (hi == 0) li_l[r32] = l_reg; asm volatile("s_waitcnt lgkmcnt(0)" ::: "memory");
    float rli[16];
#pragma unroll
    for (int r = 0; r < 16; ++r) rli[r] = __builtin_amdgcn_rcpf(li_l[crow(r, hi)]);
#pragma unroll
    for (int r = 0; r < 16; r += 1) { const int orow = crow(r, hi);
#pragma unroll
        for (int d0 = 0; d0 < 2; ++d0) stg[orow * 64 + d0 * 32 + r32] = (bf16_t)(cvtpk(o[d0][r] * rli[r], 0.f) & 0xffffu); }
    asm volatile("s_waitcnt lgkmcnt(0)" ::: "memory");
    bf16_t* Ow = Ob + (size_t)(wid * 32) * 1024;
#pragma unroll
    for (int i = 0; i < 4; ++i) { const int row = i * 8 + (lane >> 3), ch = lane & 7; const u32x4 v = *(const u32x4*)(stg + row * 64 + ch * 8); *(u32x4*)(Ow + (size_t)row * 1024 + ch * 8) = v; }
    __syncthreads();
#undef SLOAD
#undef SWRITE
#undef SWAIT
}

__device__ __forceinline__ void mla_phase(const Params& p, char* lds, int p_tid) {
    const bf16_t* Q = (const bf16_t*)(p.ws + WS_U + U_Q); const bf16_t* KV = (const bf16_t*)(p.ws + WS_U + U_KV); const bf16_t* KR = (const bf16_t*)(p.ws + WS_U + U_KR);
    bf16_t* H = (bf16_t*)(p.ws + WS_H);
    for (int u = blockIdx.x; u < 1536; u += gridDim.x) {
        int tok0, qb, h, seq;
        if (u < 1024) { const int i = u >> 8, c = u & 255, bh = i * 8 + (c & 7); qb = c >> 3; h = bh & 7; tok0 = (bh >> 3) * 8192; seq = 8192; }
        else { const int u2 = u - 1024, i = u2 >> 8, c = u2 & 255, bh = (i * 8 + (c & 7)) * 4 + (c >> 6); qb = (c >> 3) & 7; h = bh & 7; tok0 = MPROMPT + (bh >> 3) * 2048; seq = 2048; }
        const int q0 = tok0 + qb * 256;
        mla_unit(Q + (size_t)q0 * 768 + h * 96, KV + (size_t)tok0 * 1024 + h * 128, KR + (size_t)tok0 * 32, H + (size_t)q0 * 1024 + h * 64, seq, qb * 256, (const float*)(p.ws + WS_COS), (const float*)(p.ws + WS_SIN), lds, p_tid);
    }
}

__device__ __forceinline__ void dil_qkt(f32x16& p0, f32x16& p1, const char* Ks, const bf16x8* qr, int r32, int hi) {
    p0 = f32x16{}; p1 = f32x16{};
#pragma unroll
    for (int d0 = 0; d0 < 4; ++d0) { const int cb = (d0 * 16 + hi * 8) * 2;
        const bf16x8 b0 = *reinterpret_cast<const bf16x8*>(Ks + KSWZ64(r32, cb));
        const bf16x8 b1 = *reinterpret_cast<const bf16x8*>(Ks + KSWZ64(32 + r32, cb));
        p0 = __builtin_amdgcn_mfma_f32_32x32x16_bf16(b0, qr[d0], p0, 0, 0, 0);
        p1 = __builtin_amdgcn_mfma_f32_32x32x16_bf16(b1, qr[d0], p1, 0, 0, 0); }
}
struct DilU { int tokbase, L, d, rr, h, br, I0; };
__device__ __forceinline__ DilU dil_decode(int u) {
    int seg, b, br, rr, qb, hd;
    if (u < 3072) { seg = 0; const int bh = u / 96; b = bh >> 3; hd = bh & 7; const int rem = u % 96; br = rem >> 5; const int x = rem & 31;
        if (br == 0) { rr = 0; qb = x; } else if (br == 1) { rr = x & 3; qb = x >> 2; } else { rr = x & 15; qb = x >> 4; } }
    else { seg = 1; const int u2 = u - 3072; const int bh = u2 >> 5; b = bh >> 3; hd = bh & 7; const int rem = u2 & 31;
        if (rem < 8) { br = 0; rr = 0; qb = rem; } else if (rem < 16) { br = 1; rr = (rem - 8) & 3; qb = (rem - 8) >> 2; } else { br = 2; rr = rem - 16; qb = 0; } }
    DilU r; r.h = hd; r.br = br; r.rr = rr; r.I0 = qb * 256;
    r.tokbase = seg ? MPROMPT + b * 2048 : b * 8192;
    r.d = br == 0 ? 1 : (br == 1 ? 4 : 16); r.L = (seg ? 2048 : 8192) / r.d;
    return r;
}
__device__ __forceinline__ void dil_phase(const Params& p, char* lds, int p_tid) {
    const bf16_t* ZD = (const bf16_t*)(p.ws + WS_U + U_ZD);
    const int tid = p_tid, wid = tid >> 6, lane = tid & 63, r32 = lane & 31, hi = lane >> 5;
    char* K_lds = lds; char* V_lds = lds + 6 * 8192;
    float* wsf = (float*)(lds + 12 * 8192) + wid * 64; float* li_l = wsf; float* al_l = wsf + 32;
    bf16_t* stg = (bf16_t*)(lds + 12 * 8192 + 2048) + wid * 2048;
    const int skey = tid >> 3, sc = (tid & 7) * 8;
    const int kst = KSWZ64(skey, sc * 2), vst = v_st(skey, sc);
    const int vb0 = (int)(uintptr_t)V_lds + v_rd_base(lane);
#define DIL_LOAD(U) bf16x8 kreg[6], vreg[6], qreg[4]; do { const int KB_ = (U).I0 - 64; \
        _Pragma("unroll") for (int T = 0; T < 6; ++T) { int kf = KB_ + 64 * T + skey; kf = kf < 0 ? 0 : (kf > (U).L - 1 ? (U).L - 1 : kf); \
            const size_t ro = (size_t)((U).tokbase + kf * (U).d + (U).rr) * 64 + sc; \
            kreg[T] = *reinterpret_cast<const bf16x8*>(ZD + (size_t)(8 + (U).h) * MTOK * 64 + ro); vreg[T] = *reinterpret_cast<const bf16x8*>(ZD + (size_t)(16 + (U).h) * MTOK * 64 + ro); } \
        { int qfc = (U).I0 + wid * 32 + r32; qfc = qfc > (U).L - 1 ? (U).L - 1 : qfc; \
          const bf16_t* qp = ZD + (size_t)(U).h * MTOK * 64 + (size_t)((U).tokbase + qfc * (U).d + (U).rr) * 64 + hi * 8; \
          _Pragma("unroll") for (int d0 = 0; d0 < 4; ++d0) qreg[d0] = *reinterpret_cast<const bf16x8*>(qp + d0 * 16); } } while (0)
    for (int u = blockIdx.x; u < 5120; u += gridDim.x) {
        const DilU cur = dil_decode(u);
        bf16x8 qr[4];
        { DIL_LOAD(cur);
#pragma unroll
          for (int T = 0; T < 6; ++T) { *(bf16x8*)(K_lds + T * 8192 + kst) = kreg[T]; *(bf16x8*)(V_lds + T * 8192 + vst) = vreg[T]; }
#pragma unroll
          for (int d0 = 0; d0 < 4; ++d0) qr[d0] = qreg[d0]; }
        __syncthreads();
        const int L = cur.L, d = cur.d, I0 = cur.I0, KB = I0 - 64, h = cur.h, rr = cur.rr, tokbase = cur.tokbase;
        bf16_t* OB = (bf16_t*)(p.ws + WS_U + U_OB) + (size_t)cur.br * MTOK * 512;
        f32x2* ML = (f32x2*)(p.ws + WS_U + U_ML) + (size_t)cur.br * MTOK * 8;
        const int qf = I0 + wid * 32 + r32;
        const bool wv = (I0 + wid * 32) < L;
        const bool edge = (KB < 0) || (KB + 384 > L);
        float m_reg = -1e30f, l_reg = 0.f; f32x16 o[2] = {};
        if (wv) {
            const float nsl = -__builtin_amdgcn_exp2f(-(float)(h + 1)) * (float)d * LOG2E;
            const float kh = (float)(4 * hi);
            const int T0 = wid >> 1;
            f32x16 P[3][2];
#pragma unroll
            for (int tt = 0; tt < 3; ++tt) { P[tt][0] = f32x16{}; P[tt][1] = f32x16{}; }
#pragma unroll
            for (int d0 = 0; d0 < 4; ++d0) { const int cb = (d0 * 16 + hi * 8) * 2;
#pragma unroll
                for (int tt = 0; tt < 3; ++tt) { const char* Ks = K_lds + (T0 + tt) * 8192;
                    const bf16x8 b0 = *reinterpret_cast<const bf16x8*>(Ks + KSWZ64(r32, cb)), b1 = *reinterpret_cast<const bf16x8*>(Ks + KSWZ64(32 + r32, cb));
                    P[tt][0] = __builtin_amdgcn_mfma_f32_32x32x16_bf16(b0, qr[d0], P[tt][0], 0, 0, 0);
                    P[tt][1] = __builtin_amdgcn_mfma_f32_32x32x16_bf16(b1, qr[d0], P[tt][1], 0, 0, 0); } }
            float pm0 = -3.0e38f, pm1 = -3.0e38f;
#pragma unroll
            for (int tt = 0; tt < 3; ++tt) {
                const int kbase = KB + 64 * (T0 + tt);
                const float rbh = (float)(kbase - qf) + kh;
                if (!edge) {
#pragma unroll
                    for (int r = 0; r < 16; ++r) {
                        const float c_r = (float)((r & 3) + 8 * (r >> 2));
                        const float a0 = __builtin_fabsf(rbh + c_r), a1 = __builtin_fabsf(rbh + (c_r + 32.f));
                        const float s0 = fmaf(a0, nsl, P[tt][0][r]), s1 = fmaf(a1, nsl, P[tt][1][r]);
                        P[tt][0][r] = (a0 <= 64.f) ? s0 : -1e30f; P[tt][1][r] = (a1 <= 64.f) ? s1 : -1e30f;
                        pm0 = fmaxf(pm0, P[tt][0][r]); pm1 = fmaxf(pm1, P[tt][1][r]);
                    }
                } else {
                    const float klo = (float)(-kbase) - kh, khi_ = (float)(L - kbase) - kh;
#pragma unroll
                    for (int r = 0; r < 16; ++r) {
                        const float c_r = (float)((r & 3) + 8 * (r >> 2));
                        const float a0 = __builtin_fabsf(rbh + c_r), a1 = __builtin_fabsf(rbh + (c_r + 32.f));
                        const float s0 = fmaf(a0, nsl, P[tt][0][r]), s1 = fmaf(a1, nsl, P[tt][1][r]);
                        P[tt][0][r] = ((a0 <= 64.f) && (c_r >= klo) && (c_r < khi_)) ? s0 : -1e30f;
                        P[tt][1][r] = ((a1 <= 64.f) && (c_r + 32.f >= klo) && (c_r + 32.f < khi_)) ? s1 : -1e30f;
                        pm0 = fmaxf(pm0, P[tt][0][r]); pm1 = fmaxf(pm1, P[tt][1][r]);
                    }
                }
            }
            float pmax = fmaxf(pm0, pm1);
            { auto rr2 = __builtin_amdgcn_permlane32_swap(__float_as_uint(pmax), __float_as_uint(pmax), false, false);
              pmax = fmaxf(__uint_as_float(rr2[0]), __uint_as_float(rr2[1])); }
            m_reg = pmax;
            float ps0 = 0.f, ps1 = 0.f;
#pragma unroll
            for (int tt = 0; tt < 3; ++tt)
#pragma unroll
                for (int r = 0; r < 16; ++r) { P[tt][0][r] = __builtin_amdgcn_exp2f(P[tt][0][r] - pmax); P[tt][1][r] = __builtin_amdgcn_exp2f(P[tt][1][r] - pmax); ps0 += P[tt][0][r]; ps1 += P[tt][1][r]; }
            float ps = ps0 + ps1;
            { auto rr2 = __builtin_amdgcn_permlane32_swap(__float_as_uint(ps), __float_as_uint(ps), false, false);
              ps = __uint_as_float(rr2[0]) + __uint_as_float(rr2[1]); }
            l_reg = ps;
#pragma unroll
            for (int tt = 0; tt < 3; ++tt) {
                bf16x8 pa0, pa1, pa2, pa3;
                PK4(P[tt][0], 0, pa0); PK4(P[tt][0], 8, pa1); PK4(P[tt][1], 0, pa2); PK4(P[tt][1], 8, pa3);
                pv2(o, vb0 + (T0 + tt) * 8192, pa0, pa1, pa2, pa3);
            }
        }
        if (wv) {
            if (hi == 0) { li_l[r32] = l_reg; ML[(size_t)(tokbase + qf * d + rr) * 8 + h] = (f32x2){m_reg, l_reg}; }
            asm volatile("s_waitcnt lgkmcnt(0)" ::: "memory");
            float rli[16];
#pragma unroll
            for (int r = 0; r < 16; ++r) rli[r] = __builtin_amdgcn_rcpf(li_l[crow(r, hi)]);
#pragma unroll
            for (int r = 0; r < 16; ++r) { const int orow = crow(r, hi);
#pragma unroll
                for (int d0 = 0; d0 < 2; ++d0) stg[orow * 64 + d0 * 32 + r32] = (bf16_t)(cvtpk(o[d0][r] * rli[r], 0.f) & 0xffffu); }
            asm volatile("s_waitcnt lgkmcnt(0)" ::: "memory");
#pragma unroll
            for (int i = 0; i < 4; ++i) { const int row = i * 8 + (lane >> 3), ch = lane & 7; const u32x4 v = *(const u32x4*)(stg + row * 64 + ch * 8);
                const int qrow = I0 + wid * 32 + row;
                *(u32x4*)(OB + (size_t)(tokbase + qrow * d + rr) * 512 + h * 64 + ch * 8) = v; }
        }
        __syncthreads();
    }
#undef DIL_LOAD
}
#undef RESC


template <int L>
__device__ __forceinline__ void layer_phase(const Params& p, int s, char* lds, int wave) {
    const int p_tid = phase_tid(wave);
    unsigned char* ws = p.ws;
    bf16_t* H = (bf16_t*)(ws + WS_H); bf16_t* U = (bf16_t*)(ws + WS_U);
    EpiArgs e{}; e.cosT = (const float*)(ws + WS_COS); e.sinT = (const float*)(ws + WS_SIN);
    if (s == 0) {
        e.o0 = (bf16_t*)(ws + WS_U + U_LAT); e.o1 = (bf16_t*)(ws + WS_U + U_ZD);
        gemm_phase<EPI_Z, 2048, 1024, 0>(H, (const bf16_t*)(ws + WS_WIN), e, lds, p_tid);
    } else if (s == 1) {
        latent_pass(p, L, p_tid);
        dil_phase(p, lds, p_tid);
    } else if (s == 2) {
        e.o0 = (bf16_t*)(ws + WS_U + U_Q);
        gemm_phase<EPI_QSCALE, 768, 256, 768>((const bf16_t*)(ws + WS_U + U_LQN), (const bf16_t*)(ws + WS_WUQ), e, lds, p_tid);
        __syncthreads();
        e.o0 = (bf16_t*)(ws + WS_U + U_KV);
        gemm_phase<EPI_PLAIN, 1024, 128, 1024, false>((const bf16_t*)(ws + WS_U + U_LKVN), (const bf16_t*)(ws + WS_WUKV), e, lds, phase_tid(wave));
    } else if (s == 3) {
        mla_phase(p, lds, p_tid);
    } else if (s == 4) {
        combine_pass(p, L, p_tid);
    } else if (s == 5) {
        e.o0 = (bf16_t*)(ws + WS_U + U_MIX);
        gemm_phase<EPI_PLAIN, 1024, 1024, 1024>(H, (const bf16_t*)(ws + WS_WOUT), e, lds, p_tid);
    } else if (s == 6) {
        rowpass(p, L == 0, (const bf16_t*)(ws + WS_U + U_MIX), p.in[11] + L * 1024, p.in[12] + L * 1024, H, p_tid, false);
    } else if (s == 7) {
        e.o0 = U;
        gemm_phase<EPI_RELU2, 4096, 1024, 4096>(H, (const bf16_t*)(ws + WS_WUP), e, lds, p_tid);
    } else if (s == 8) {
        e.o0 = H;
        gemm_phase<EPI_PLAIN, 1024, 4096, 1024>(U, (const bf16_t*)(ws + WS_WDN), e, lds, p_tid);
    } else {
        if (L + 1 < DEPTH) convert_weights(p, L + 1, lds, p_tid);
        rowpass(p, false, H, p.in[15] + L * 1024, (L + 1 < DEPTH) ? p.in[2] + (L + 1) * 1024 : nullptr, H, p_tid, L + 1 == DEPTH);
    }
}

__device__ __forceinline__ void grid_barrier(unsigned* cnt, unsigned target, int p_tid) {
    asm volatile("s_waitcnt vmcnt(0) lgkmcnt(0)" ::: "memory");
    __syncthreads();
    if ((p_tid >> 6) == 0) {
        __builtin_amdgcn_fence(__ATOMIC_RELEASE, "agent");
        asm volatile("s_waitcnt vmcnt(0)" ::: "memory");
        if (p_tid == 0) {
            __hip_atomic_fetch_add(cnt, 1u, __ATOMIC_RELAXED, __HIP_MEMORY_SCOPE_AGENT);
            while (__hip_atomic_load(cnt, __ATOMIC_RELAXED, __HIP_MEMORY_SCOPE_AGENT) < target) __builtin_amdgcn_s_sleep(1);
        }
        __builtin_amdgcn_fence(__ATOMIC_ACQUIRE, "agent");
        asm volatile("s_waitcnt vmcnt(0)" ::: "memory");
    }
    __syncthreads();
}

constexpr int PH_PER_LAYER = 10;
constexpr int NPHASE = 1 + PH_PER_LAYER * DEPTH;

__global__ void __launch_bounds__(NTHREADS) fwd_megakernel(Params p) {
    extern __shared__ __attribute__((aligned(16))) char shm[];
    const int lo = p.ph_lo, hi = p.ph_hi;
    const int wave = __builtin_amdgcn_readfirstlane((int)(threadIdx.x >> 6));
    unsigned* bar_cnt = (unsigned*)(p.ws + WS_BAR);
    if (hi - lo > 1) {
        if (blockIdx.x == 0 && threadIdx.x == 0) __hip_atomic_store(bar_cnt, 0u, __ATOMIC_RELAXED, __HIP_MEMORY_SCOPE_AGENT);
        cg::this_grid().sync();
    }
    const unsigned nblk = gridDim.x;
#ifndef DUP_MASK
#define DUP_MASK 0
#endif
#define PHASE(k, body) if (lo <= (k) && (k) < hi) { body; if ((DUP_MASK >> (k)) & 1) { __syncthreads(); body; } if ((k) + 1 < hi) grid_barrier(bar_cnt, (unsigned)((k) - lo + 1) * nblk, phase_tid(wave)); }
    PHASE(0, { const int p_tid = phase_tid(wave); convert_weights(p, 0, shm, p_tid); rope_table(p, p_tid); rowpass(p, true, nullptr, nullptr, p.in[2], (bf16_t*)(p.ws + WS_H), p_tid, false); })
    PHASE(1, layer_phase<0>(p, 0, shm, wave))
    PHASE(2, layer_phase<0>(p, 1, shm, wave))
    PHASE(3, layer_phase<0>(p, 2, shm, wave))
    PHASE(4, layer_phase<0>(p, 3, shm, wave))
    PHASE(5, layer_phase<0>(p, 4, shm, wave))
    PHASE(6, layer_phase<0>(p, 5, shm, wave))
    PHASE(7, layer_phase<0>(p, 6, shm, wave))
    PHASE(8, layer_phase<0>(p, 7, shm, wave))
    PHASE(9, layer_phase<0>(p, 8, shm, wave))
    PHASE(10, layer_phase<0>(p, 9, shm, wave))
    PHASE(11, layer_phase<1>(p, 0, shm, wave))
    PHASE(12, layer_phase<1>(p, 1, shm, wave))
    PHASE(13, layer_phase<1>(p, 2, shm, wave))
    PHASE(14, layer_phase<1>(p, 3, shm, wave))
    PHASE(15, layer_phase<1>(p, 4, shm, wave))
    PHASE(16, layer_phase<1>(p, 5, shm, wave))
    PHASE(17, layer_phase<1>(p, 6, shm, wave))
    PHASE(18, layer_phase<1>(p, 7, shm, wave))
    PHASE(19, layer_phase<1>(p, 8, shm, wave))
    PHASE(20, layer_phase<1>(p, 9, shm, wave))
#undef PHASE
}

extern "C" void kernel_launch(void* const* d_in, const int* in_sizes, int n_in, void* d_out, int out_size, void* d_ws, size_t ws_size, hipStream_t stream) {
    static int grid_blocks = 0;
    if (grid_blocks == 0) {
        if (n_in != 16 || out_size != MTOK * DM || ws_size < WS_END) {
            fprintf(stderr, "kernel_launch: shape/workspace mismatch: n_in %d out %d ws %zu (need %zu)\n", n_in, out_size, ws_size, (size_t)WS_END);
            grid_blocks = -1; return;
        }
        int dev = 0, cus = 0, per_cu = 0;
        hipGetDevice(&dev);
        hipDeviceGetAttribute(&cus, hipDeviceAttributeMultiprocessorCount, dev);
        if (hipFuncSetAttribute((const void*)fwd_megakernel, hipFuncAttributeMaxDynamicSharedMemorySize, LDS_BYTES) != hipSuccess) {
            fprintf(stderr, "kernel_launch: hipFuncSetAttribute failed\n"); grid_blocks = -1; return;
        }
        hipOccupancyMaxActiveBlocksPerMultiprocessor(&per_cu, (const void*)fwd_megakernel, NTHREADS, LDS_BYTES);
        if (per_cu < 1) per_cu = 1;
        if (per_cu > 1) per_cu = 1;
        grid_blocks = cus * per_cu;
        (void)hipGetLastError();
    }
    if (grid_blocks < 0) return;
    Params p{};
    for (int i = 0; i < 16; ++i) p.in[i] = (const float*)d_in[i];
    p.out = (float*)d_out; p.ws = (unsigned char*)d_ws;
#if MK_MULTI
    for (int ph = 0; ph < NPHASE; ++ph) {
        p.ph_lo = ph; p.ph_hi = ph + 1;
        hipLaunchKernelGGL(fwd_megakernel, dim3(grid_blocks), dim3(NTHREADS), LDS_BYTES, stream, p);
    }
#else
    p.ph_lo = 0; p.ph_hi = NPHASE;
    void* args[] = {&p};
    hipError_t e = hipLaunchCooperativeKernel((const void*)fwd_megakernel, dim3(grid_blocks), dim3(NTHREADS), args, LDS_BYTES, stream);
    if (e != hipSuccess) fprintf(stderr, "cooperative launch failed: %s (grid %d)\n", hipGetErrorString(e), grid_blocks);
#endif
}
```

```cpp
#include <hip/hip_runtime.h>
#include <hip/hip_cooperative_groups.h>
#include <cstdio>
#include <cstdint>
namespace cg = cooperative_groups;

#ifndef MK_MULTI
#define MK_MULTI 0
#endif

typedef unsigned short bf16_t;
typedef short bf16x8 __attribute__((ext_vector_type(8)));
typedef short s16x4 __attribute__((ext_vector_type(4)));
typedef float f32x4 __attribute__((ext_vector_type(4)));
typedef float f32x2 __attribute__((ext_vector_type(2)));
typedef float f32x16 __attribute__((ext_vector_type(16)));
typedef unsigned u32x4 __attribute__((ext_vector_type(4)));
#define LAS __attribute__((address_space(3)))

constexpr int MTOK = 49152, MPROMPT = 32768, DM = 1024, DEPTH = 2, DFF = 4096;
constexpr int NTHREADS = 512;
constexpr int LDS_BYTES = 144 * 1024;
constexpr float EPS = 1e-6f;
constexpr float LOG2E = 1.4426950408889634f;

constexpr size_t WS_WIN = 0;
constexpr size_t WS_WUQ = WS_WIN + (size_t)2048 * 1024 * 2;
constexpr size_t WS_WUKV = WS_WUQ + (size_t)768 * 256 * 2;
constexpr size_t WS_WOUT = WS_WUKV + (size_t)1024 * 128 * 2;
constexpr size_t WS_WUP = WS_WOUT + (size_t)1024 * 1024 * 2;
constexpr size_t WS_WDN = WS_WUP + (size_t)4096 * 1024 * 2;
constexpr size_t WS_COS = WS_WDN + (size_t)4096 * 1024 * 2;
constexpr size_t WS_SIN = WS_COS + (size_t)8192 * 16 * 4;
constexpr size_t WS_H = WS_SIN + (size_t)8192 * 16 * 4;
constexpr size_t WS_U = WS_H + (size_t)MTOK * 1024 * 2;
constexpr size_t WS_BAR = WS_U + (size_t)MTOK * 4096 * 2;
constexpr size_t WS_END = WS_BAR + 256;
constexpr size_t U_ZD = 0;
constexpr size_t U_Q = 0;
constexpr size_t U_KV = U_Q + (size_t)MTOK * 768 * 2;
constexpr size_t U_LAT = U_ZD + (size_t)MTOK * 1536 * 2;
constexpr size_t U_OB = U_LAT + (size_t)MTOK * 512 * 2;
constexpr size_t U_MIX = U_OB;
constexpr size_t U_LQN = U_OB + (size_t)3 * MTOK * 512 * 2;
constexpr size_t U_LKVN = U_LQN + (size_t)MTOK * 256 * 2;
constexpr size_t U_KR = U_LKVN + (size_t)MTOK * 128 * 2;
constexpr size_t U_ML = U_KR + (size_t)MTOK * 32 * 2;
static_assert(U_ML + (size_t)3 * MTOK * 8 * 8 <= (size_t)MTOK * 4096 * 2, "mixer overlay exceeds U");
static_assert(U_KV + (size_t)MTOK * 1024 * 2 <= U_OB, "KV overlay");

struct Params {
    const float* in[16];
    float* out;
    unsigned char* ws;
    int ph_lo, ph_hi;
};

__device__ __forceinline__ int phase_tid(int wave) { int l; asm volatile("v_mbcnt_lo_u32_b32 %0, -1, 0\n\tv_mbcnt_hi_u32_b32 %0, -1, %0" : "=v"(l)); return wave * 64 + l; }
__device__ __forceinline__ unsigned cvtpk(float lo, float hi) { unsigned r; asm("v_cvt_pk_bf16_f32 %0, %1, %2" : "=v"(r) : "v"(lo), "v"(hi)); return r; }
__device__ __forceinline__ float bf2f(unsigned short b) { return __uint_as_float(((unsigned)b) << 16); }
__device__ __forceinline__ float bflo(unsigned w) { return __uint_as_float(w << 16); }
__device__ __forceinline__ float bfhi(unsigned w) { return __uint_as_float(w & 0xffff0000u); }
__device__ __forceinline__ float wave_sum(float v) {
#pragma unroll
    for (int o = 32; o >= 1; o >>= 1) v += __shfl_xor(v, o);
    return v;
}
__device__ __forceinline__ int tok_pos(int t) { return t < MPROMPT ? (t & 8191) : (t & 2047); }

__device__ __forceinline__ void wconv(const float* __restrict__ src, bf16_t* __restrict__ dst, int K, int Nsrc, int Ndst, int mode, char* lds, int p_tid) {
    float* tile = (float*)lds;
    const int tid = p_tid;
    const int ntn = Ndst / 64, ntk = K / 64;
    for (int tIdx = blockIdx.x; tIdx < ntn * ntk; tIdx += gridDim.x) {
        const int tn = tIdx / ntk, tk = tIdx % ntk;
        const int kr = tid >> 3, nc = (tid & 7) * 8;
        const int nd = tn * 64 + nc;
        int ns = nd;
        if (mode == 1) ns = nd < 416 ? nd : (nd < 512 ? -1 : nd - 96);
        f32x4 a = {0.f, 0.f, 0.f, 0.f}, b = {0.f, 0.f, 0.f, 0.f};
        if (ns >= 0) { const float* s = src + (size_t)(tk * 64 + kr) * Nsrc + ns; a = *(const f32x4*)s; b = *(const f32x4*)(s + 4); }
        float* t = tile + kr * 65 + nc;
        t[0] = a[0]; t[1] = a[1]; t[2] = a[2]; t[3] = a[3]; t[4] = b[0]; t[5] = b[1]; t[6] = b[2]; t[7] = b[3];
        __syncthreads();
        const int nr = tid >> 3, kc = (tid & 7) * 8;
        float v[8];
#pragma unroll
        for (int j = 0; j < 8; ++j) v[j] = tile[(kc + j) * 65 + nr];
        u32x4 w = {cvtpk(v[0], v[1]), cvtpk(v[2], v[3]), cvtpk(v[4], v[5]), cvtpk(v[6], v[7])};
        *(u32x4*)(dst + (size_t)(tn * 64 + nr) * K + tk * 64 + kc) = w;
        __syncthreads();
    }
}
__device__ __forceinline__ void convert_weights(const Params& p, int l, char* lds, int p_tid) {
    unsigned char* ws = p.ws;
    wconv(p.in[3] + (size_t)l * 1024 * 1952, (bf16_t*)(ws + WS_WIN), 1024, 1952, 2048, 1, lds, p_tid);
    wconv(p.in[5] + (size_t)l * 256 * 768, (bf16_t*)(ws + WS_WUQ), 256, 768, 768, 0, lds, p_tid);
    wconv(p.in[7] + (size_t)l * 128 * 1024, (bf16_t*)(ws + WS_WUKV), 128, 1024, 1024, 0, lds, p_tid);
    wconv(p.in[10] + (size_t)l * 1024 * 1024, (bf16_t*)(ws + WS_WOUT), 1024, 1024, 1024, 0, lds, p_tid);
    wconv(p.in[13] + (size_t)l * 1024 * 4096, (bf16_t*)(ws + WS_WUP), 1024, 4096, 4096, 0, lds, p_tid);
    wconv(p.in[14] + (size_t)l * 4096 * 1024, (bf16_t*)(ws + WS_WDN), 4096, 1024, 1024, 0, lds, p_tid);
}
__device__ __forceinline__ void rope_table(const Params& p, int p_tid) {
    float* cosT = (float*)(p.ws + WS_COS); float* sinT = (float*)(p.ws + WS_SIN);
    for (int idx = blockIdx.x * NTHREADS + p_tid; idx < 8192 * 16; idx += gridDim.x * NTHREADS) {
        const int s = idx >> 4, i = idx & 15;
        double f = 1.0;
        for (int j = 0; j < i; ++j) f *= 0.5623413251903491;
        const float invf = (float)f;
        const float ang = (float)s * invf;
        double rev = (double)ang * 0.15915494309189535;
        rev -= rint(rev);
        const float fr = (float)rev;
        cosT[idx] = __builtin_amdgcn_cosf(fr);
        sinT[idx] = __builtin_amdgcn_sinf(fr);
    }
}

constexpr int RP = 2;
__device__ __forceinline__ void rowpass(const Params& p, bool x_from_input, const bf16_t* branch, const float* g1, const float* g2, bf16_t* hdst, int p_tid, bool out_f32) {
    const int wid = p_tid >> 6, lane = p_tid & 63;
    for (int row0 = (blockIdx.x * 8 + wid) * RP; row0 < MTOK; row0 += gridDim.x * 8 * RP) {
        float v[RP][16]; float bv[RP][16];
#pragma unroll
        for (int q = 0; q < RP; ++q) {
            const int row = row0 + q;
            if (x_from_input) {
                const float* xr = (row < MPROMPT ? p.in[0] + (size_t)row * DM : p.in[1] + (size_t)(row - MPROMPT) * DM);
#pragma unroll
                for (int i = 0; i < 2; ++i) {
                    const int e0 = lane * 8 + i * 512;
                    const f32x4 a = *(const f32x4*)(xr + e0), b = *(const f32x4*)(xr + e0 + 4);
                    v[q][i * 8 + 0] = a[0]; v[q][i * 8 + 1] = a[1]; v[q][i * 8 + 2] = a[2]; v[q][i * 8 + 3] = a[3];
                    v[q][i * 8 + 4] = b[0]; v[q][i * 8 + 5] = b[1]; v[q][i * 8 + 6] = b[2]; v[q][i * 8 + 7] = b[3];
                }
            } else {
                const bf16_t* xr = (const bf16_t*)(p.out + (size_t)row * DM + 512);
#pragma unroll
                for (int i = 0; i < 2; ++i) {
                    const u32x4 w = *(const u32x4*)(xr + lane * 8 + i * 512);
#pragma unroll
                    for (int j = 0; j < 4; ++j) { v[q][i * 8 + 2 * j] = bflo(w[j]); v[q][i * 8 + 2 * j + 1] = bfhi(w[j]); }
                }
            }
            if (branch) {
#pragma unroll
                for (int i = 0; i < 2; ++i) {
                    const u32x4 w = *(const u32x4*)(branch + (size_t)row * DM + lane * 8 + i * 512);
#pragma unroll
                    for (int j = 0; j < 4; ++j) { bv[q][i * 8 + 2 * j] = bflo(w[j]); bv[q][i * 8 + 2 * j + 1] = bfhi(w[j]); }
                }
            }
        }
        f32x4 ga1[2][2], ga2[2][2];
#pragma unroll
        for (int i = 0; i < 2; ++i) {
            const int e0 = lane * 8 + i * 512;
            if (branch) { ga1[i][0] = *(const f32x4*)(g1 + e0); ga1[i][1] = *(const f32x4*)(g1 + e0 + 4); }
            if (g2) { ga2[i][0] = *(const f32x4*)(g2 + e0); ga2[i][1] = *(const f32x4*)(g2 + e0 + 4); }
        }
#pragma unroll
        for (int q = 0; q < RP; ++q) {
            const int row = row0 + q;
            if (branch) {
                float ss = 0.f;
#pragma unroll
                for (int j = 0; j < 16; ++j) ss += bv[q][j] * bv[q][j];
                ss = wave_sum(ss);
                const float r = rsqrtf(ss * (1.0f / 1024.0f) + EPS);
#pragma unroll
                for (int i = 0; i < 2; ++i) {
                    const int e0 = lane * 8 + i * 512;
#pragma unroll
                    for (int j = 0; j < 4; ++j) { v[q][i * 8 + j] += bv[q][i * 8 + j] * r * ga1[i][0][j]; v[q][i * 8 + 4 + j] += bv[q][i * 8 + 4 + j] * r * ga1[i][1][j]; }
                    if (out_f32) {
                        float* o = p.out + (size_t)row * DM + e0;
                        *(f32x4*)o = (f32x4){v[q][i * 8 + 0], v[q][i * 8 + 1], v[q][i * 8 + 2], v[q][i * 8 + 3]};
                        *(f32x4*)(o + 4) = (f32x4){v[q][i * 8 + 4], v[q][i * 8 + 5], v[q][i * 8 + 6], v[q][i * 8 + 7]};
                    } else {
                        u32x4 wx = {cvtpk(v[q][i * 8 + 0], v[q][i * 8 + 1]), cvtpk(v[q][i * 8 + 2], v[q][i * 8 + 3]), cvtpk(v[q][i * 8 + 4], v[q][i * 8 + 5]), cvtpk(v[q][i * 8 + 6], v[q][i * 8 + 7])};
                        *(u32x4*)((bf16_t*)(p.out + (size_t)row * DM + 512) + e0) = wx;
                    }
                }
            }
            if (g2) {
                float ss = 0.f;
#pragma unroll
                for (int j = 0; j < 16; ++j) ss += v[q][j] * v[q][j];
                ss = wave_sum(ss);
                const float r = rsqrtf(ss * (1.0f / 1024.0f) + EPS);
#pragma unroll
                for (int i = 0; i < 2; ++i) {
                    const int e0 = lane * 8 + i * 512;
                    float h[8];
#pragma unroll
                    for (int j = 0; j < 4; ++j) { h[j] = v[q][i * 8 + j] * r * ga2[i][0][j]; h[4 + j] = v[q][i * 8 + 4 + j] * r * ga2[i][1][j]; }
                    u32x4 w = {cvtpk(h[0], h[1]), cvtpk(h[2], h[3]), cvtpk(h[4], h[5]), cvtpk(h[6], h[7])};
                    *(u32x4*)(hdst + (size_t)row * DM + e0) = w;
                }
            }
        }
    }
}

__device__ __forceinline__ void latent_pass(const Params& p, int l, int p_tid) {
    const int wid = p_tid >> 6, lane = p_tid & 63;
    const bf16_t* LAT = (const bf16_t*)(p.ws + WS_U + U_LAT);
    bf16_t* LQN = (bf16_t*)(p.ws + WS_U + U_LQN); bf16_t* LKVN = (bf16_t*)(p.ws + WS_U + U_LKVN); bf16_t* KR = (bf16_t*)(p.ws + WS_U + U_KR);
    const float* gq = p.in[4] + l * 256; const float* gkv = p.in[6] + l * 128;
    const float* cosT = (const float*)(p.ws + WS_COS); const float* sinT = (const float*)(p.ws + WS_SIN);
    for (int row = blockIdx.x * 8 + wid; row < MTOK; row += gridDim.x * 8) {
        const u32x4 w = *(const u32x4*)(LAT + (size_t)row * 512 + lane * 8);
        float v[8];
#pragma unroll
        for (int j = 0; j < 4; ++j) { v[2 * j] = bflo(w[j]); v[2 * j + 1] = bfhi(w[j]); }
        float ss = 0.f;
#pragma unroll
        for (int j = 0; j < 8; ++j) ss += v[j] * v[j];
        const float sq = wave_sum(lane < 32 ? ss : 0.f);
        const float skv = wave_sum((lane >= 32 && lane < 48) ? ss : 0.f);
        float other[8];
#pragma unroll
        for (int j = 0; j < 8; ++j) other[j] = __shfl_xor(v[j], 2);
        if (lane < 32) {
            const float r = rsqrtf(sq * (1.0f / 256.0f) + EPS);
            const f32x4 ga = *(const f32x4*)(gq + lane * 8), gb = *(const f32x4*)(gq + lane * 8 + 4);
            u32x4 o = {cvtpk(v[0] * r * ga[0], v[1] * r * ga[1]), cvtpk(v[2] * r * ga[2], v[3] * r * ga[3]), cvtpk(v[4] * r * gb[0], v[5] * r * gb[1]), cvtpk(v[6] * r * gb[2], v[7] * r * gb[3])};
            *(u32x4*)(LQN + (size_t)row * 256 + lane * 8) = o;
        } else if (lane < 48) {
            const int c = (lane - 32) * 8;
            const float r = rsqrtf(skv * (1.0f / 128.0f) + EPS);
            const f32x4 ga = *(const f32x4*)(gkv + c), gb = *(const f32x4*)(gkv + c + 4);
            u32x4 o = {cvtpk(v[0] * r * ga[0], v[1] * r * ga[1]), cvtpk(v[2] * r * ga[2], v[3] * r * ga[3]), cvtpk(v[4] * r * gb[0], v[5] * r * gb[1]), cvtpk(v[6] * r * gb[2], v[7] * r * gb[3])};
            *(u32x4*)(LKVN + (size_t)row * 128 + c) = o;
        } else if (lane < 52) {
            const int q = lane - 48;
            const int i0 = (q & 1) * 8;
            const int s = tok_pos(row);
            float o[8];
#pragma unroll
            for (int j = 0; j < 8; ++j) {
                const float c = cosT[s * 16 + i0 + j], sn = sinT[s * 16 + i0 + j];
                o[j] = (q < 2) ? (v[j] * c - other[j] * sn) : (other[j] * sn + v[j] * c);
            }
            u32x4 ow = {cvtpk(o[0], o[1]), cvtpk(o[2], o[3]), cvtpk(o[4], o[5]), cvtpk(o[6], o[7])};
            *(u32x4*)(KR + (size_t)row * 32 + q * 8) = ow;
        }
    }
}

__device__ __forceinline__ void combine_pass(const Params& p, int l, int p_tid) {
    const int wid = p_tid >> 6, lane = p_tid & 63;
    bf16_t* H = (bf16_t*)(p.ws + WS_H);
    const bf16_t* OB = (const bf16_t*)(p.ws + WS_U + U_OB);
    const f32x2* ML = (const f32x2*)(p.ws + WS_U + U_ML);
    const float* ga_ = p.in[8] + l * 512; const float* gd_ = p.in[9] + l * 512;
    const int c = lane * 8, hd = lane >> 3;
    const f32x4 gaa = *(const f32x4*)(ga_ + c), gab = *(const f32x4*)(ga_ + c + 4);
    const f32x4 gda = *(const f32x4*)(gd_ + c), gdb = *(const f32x4*)(gd_ + c + 4);
    for (int row0 = (blockIdx.x * 8 + wid) * RP; row0 < MTOK; row0 += gridDim.x * 8 * RP) {
        u32x4 wa[RP], wo[RP][3]; f32x2 ml[RP][3];
#pragma unroll
        for (int q = 0; q < RP; ++q) {
            const int row = row0 + q;
            wa[q] = *(const u32x4*)(H + (size_t)row * DM + c);
#pragma unroll
            for (int i = 0; i < 3; ++i) { ml[q][i] = ML[((size_t)i * MTOK + row) * 8 + hd]; wo[q][i] = *(const u32x4*)(OB + ((size_t)i * MTOK + row) * 512 + c); }
        }
#pragma unroll
        for (int q = 0; q < RP; ++q) {
            const int row = row0 + q;
            float va[8], vd[8];
#pragma unroll
            for (int j = 0; j < 4; ++j) { va[2 * j] = bflo(wa[q][j]); va[2 * j + 1] = bfhi(wa[q][j]); }
            const float mx = fmaxf(ml[q][0][0], fmaxf(ml[q][1][0], ml[q][2][0]));
            float wsum = 0.f, wgt[3];
#pragma unroll
            for (int i = 0; i < 3; ++i) { wgt[i] = ml[q][i][1] * __builtin_amdgcn_exp2f(ml[q][i][0] - mx); wsum += wgt[i]; }
            const float inv = 1.0f / wsum;
#pragma unroll
            for (int j = 0; j < 8; ++j) vd[j] = 0.f;
#pragma unroll
            for (int i = 0; i < 3; ++i) { const float f = wgt[i] * inv;
#pragma unroll
                for (int j = 0; j < 4; ++j) { vd[2 * j] += f * bflo(wo[q][i][j]); vd[2 * j + 1] += f * bfhi(wo[q][i][j]); } }
            float sa = 0.f, sd = 0.f;
#pragma unroll
            for (int j = 0; j < 8; ++j) { sa += va[j] * va[j]; sd += vd[j] * vd[j]; }
            sa = wave_sum(sa); sd = wave_sum(sd);
            const float ra = rsqrtf(sa * (1.0f / 512.0f) + EPS), rd = rsqrtf(sd * (1.0f / 512.0f) + EPS);
            u32x4 oa = {cvtpk(va[0] * ra * gaa[0], va[1] * ra * gaa[1]), cvtpk(va[2] * ra * gaa[2], va[3] * ra * gaa[3]), cvtpk(va[4] * ra * gab[0], va[5] * ra * gab[1]), cvtpk(va[6] * ra * gab[2], va[7] * ra * gab[3])};
            u32x4 od = {cvtpk(vd[0] * rd * gda[0], vd[1] * rd * gda[1]), cvtpk(vd[2] * rd * gda[2], vd[3] * rd * gda[3]), cvtpk(vd[4] * rd * gdb[0], vd[5] * rd * gdb[1]), cvtpk(vd[6] * rd * gdb[2], vd[7] * rd * gdb[3])};
            *(u32x4*)(H + (size_t)row * DM + c) = oa;
            *(u32x4*)(H + (size_t)row * DM + 512 + c) = od;
        }
    }
}

constexpr int BM = 256, BK = 64, HALF = 128, HT = HALF * BK, NXCD = 8, WGM = 8;
__device__ __forceinline__ int lds_byte(int r, int c) { const int st = (r >> 4) * 2 + (c >> 5), rr = r & 15, cc = c & 31, ob = rr * 64 + cc * 2; return st * 1024 + (ob ^ (((ob >> 9) & 1) << 5)); }
__device__ __forceinline__ void stage_rc(int b, int& R, int& C) { const int st = b / 1024, sb = b % 1024, swz = sb ^ (((sb >> 9) & 1) << 5); R = (st >> 1) * 16 + swz / 64; C = (st & 1) * 32 + (swz % 64) / 2; }
__device__ __forceinline__ int perm32(int rho) { const int n = rho >> 4, i = rho & 15; return 8 * (i >> 2) + 4 * n + (i & 3); }

enum { EPI_PLAIN = 0, EPI_Z = 1, EPI_Q = 2, EPI_RELU2 = 3, EPI_QSCALE = 4 };
constexpr float DIL_QC = 0.125f * 1.4426950408889634f;
constexpr float MLA_QC = 0.10206207261596577f * 1.4426950408889634f;
struct EpiArgs { bf16_t* o0; bf16_t* o1; int ld; const float* cosT; const float* sinT; };

template <int EPI, int LD>
__device__ __forceinline__ void gemm_epilogue(const f32x4 (&acc)[2][2][4][2], int pm, int pn, int wid_in, const EpiArgs& e) {
    const int wid_s = __builtin_amdgcn_readfirstlane(wid_in);
    const int lane_ = phase_tid(0), wr = wid_s >> 2, wc = wid_s & 3, fr = lane_ & 15, fq = lane_ >> 4;
#pragma unroll
    for (int ai = 0; ai < 2; ++ai)
#pragma unroll
        for (int m = 0; m < 4; ++m) {
            const int row = pm * BM + ai * HALF + wr * 64 + m * 16 + fr;
#pragma unroll
            for (int bj = 0; bj < 2; ++bj) {
                const int colg = pn * BM + bj * HALF + wc * 32, col = colg + 8 * fq;
                f32x4 v0 = acc[ai][bj][m][0], v1 = acc[ai][bj][m][1];
                bf16_t* dst;
                if (EPI == EPI_Z) {
                    const int cz = col - 512;
                    dst = (pn < 2) ? e.o0 + (size_t)row * 512 + col : e.o1 + ((size_t)(cz >> 6) * MTOK + row) * 64 + (cz & 63);
                } else {
                    dst = e.o0 + (size_t)row * LD + col;
                }
                if (EPI == EPI_QSCALE) { v0 = v0 * MLA_QC; v1 = v1 * MLA_QC; }
                if (EPI == EPI_Z) { if (pn == 2 || pn == 3) { v0 = v0 * DIL_QC; v1 = v1 * DIL_QC; } }
                if (EPI == EPI_RELU2) {
#pragma unroll
                    for (int j = 0; j < 4; ++j) { float a = fmaxf(v0[j], 0.f), b = fmaxf(v1[j], 0.f); v0[j] = a * a; v1[j] = b * b; }
                }
                if (EPI == EPI_Q) {
                    if (((colg >> 5) % 3) == 2) {
                        const int s = tok_pos(row), i0 = (fq & 1) * 8;
                        const f32x4 c0 = *(const f32x4*)(e.cosT + s * 16 + i0), c1 = *(const f32x4*)(e.cosT + s * 16 + i0 + 4);
                        const f32x4 s0 = *(const f32x4*)(e.sinT + s * 16 + i0), s1 = *(const f32x4*)(e.sinT + s * 16 + i0 + 4);
#pragma unroll
                        for (int j = 0; j < 4; ++j) {
                            const float p0 = __shfl_xor(v0[j], 32), p1 = __shfl_xor(v1[j], 32);
                            v0[j] = (fq < 2) ? (v0[j] * c0[j] - p0 * s0[j]) : (p0 * s0[j] + v0[j] * c0[j]);
                            v1[j] = (fq < 2) ? (v1[j] * c1[j] - p1 * s1[j]) : (p1 * s1[j] + v1[j] * c1[j]);
                        }
                    }
                }
                u32x4 w = {cvtpk(v0[0], v0[1]), cvtpk(v0[2], v0[3]), cvtpk(v1[0], v1[1]), cvtpk(v1[2], v1[3])};
                *(u32x4*)dst = w;
            }
        }
}

template <int EPI, int N, int K, int LD, bool CONT = true>
__device__ __forceinline__ void gemm_phase(const bf16_t* __restrict__ A, const bf16_t* __restrict__ Bt, const EpiArgs& e, char* lds, int p_tid) {
    constexpr int M = MTOK;
#define SA(b, h) (((b) * 2 + (h)) * 16384)
#define SB(b, h) (65536 + ((b) * 2 + (h)) * 16384)
#define STAGE_A(P, br, kt) do { const char* _g = (const char*)(A + (size_t)(br) * K + (size_t)(kt) * BK); \
        __builtin_amdgcn_global_load_lds((const unsigned*)(_g + aoff0), (LAS unsigned*)(lds_w + (P)), 16, 0, 0); \
        __builtin_amdgcn_global_load_lds((const unsigned*)(_g + aoff1), (LAS unsigned*)(lds_w + (P) + 8192), 16, 0, 0); } while (0)
#define STAGE_B(P, br, kt) do { const char* _g = (const char*)(Bt + (size_t)(br) * K + (size_t)(kt) * BK); \
        __builtin_amdgcn_global_load_lds((const unsigned*)(_g + boff0), (LAS unsigned*)(lds_w + (P)), 16, 0, 0); \
        __builtin_amdgcn_global_load_lds((const unsigned*)(_g + boff1), (LAS unsigned*)(lds_w + (P) + 8192), 16, 0, 0); } while (0)
#define LDA(dst, b, h) _Pragma("unroll") for (int m = 0; m < 4; ++m) _Pragma("unroll") for (int k = 0; k < 2; ++k) \
        dst[m][k] = *reinterpret_cast<const LAS bf16x8*>(la_base + (((b) * 2 + (h)) * 16384 + m * 2048 + k * 1024))
#define LDB(dst, b, h) _Pragma("unroll") for (int n = 0; n < 2; ++n) _Pragma("unroll") for (int k = 0; k < 2; ++k) \
        dst[n][k] = *reinterpret_cast<const LAS bf16x8*>(lb_base + (((b) * 2 + (h)) * 16384 + n * 2048 + k * 1024))
#define MMA(ai, bj, At_, Bt_) do { __builtin_amdgcn_s_setprio(1); \
        _Pragma("unroll") for (int m = 0; m < 4; ++m) _Pragma("unroll") for (int n = 0; n < 2; ++n) _Pragma("unroll") for (int k = 0; k < 2; ++k) \
            acc[ai][bj][m][n] = __builtin_amdgcn_mfma_f32_16x16x32_bf16(Bt_[n][k], At_[m][k], acc[ai][bj][m][n], 0, 0, 0); \
        __builtin_amdgcn_s_setprio(0); } while (0)
#define WAIT_V(n) asm volatile("s_waitcnt vmcnt(" #n ")" ::: "memory")
#define WAIT_L(n) asm volatile("s_waitcnt lgkmcnt(" #n ")" ::: "memory")
#define BAR __builtin_amdgcn_s_barrier()
#define SCHED __builtin_amdgcn_sched_barrier(0)
    const int tid = p_tid, wid = tid >> 6, lane = tid & 63, wr = wid >> 2, wc = wid & 3, fr = lane & 15, fq = lane >> 4;
    const int swz_ = (fr * 64 + fq * 16) ^ ((((fr * 64 + fq * 16) >> 9) & 1) << 5);
    LAS char* lds_w = (LAS char*)lds + __builtin_amdgcn_readfirstlane(wid) * 1024;
    const LAS char* la_base = (const LAS char*)lds + wr * 8192 + swz_;
    const LAS char* lb_base = (const LAS char*)lds + 65536 + wc * 4096 + swz_;
    unsigned aoff0, aoff1, boff0, boff1;
    { int R, C; stage_rc(tid * 16, R, C); aoff0 = (unsigned)(R * K + C) * 2u; boff0 = (unsigned)(((R & ~31) | perm32(R & 31)) * K + C) * 2u;
      stage_rc(tid * 16 + 8192, R, C); aoff1 = (unsigned)(R * K + C) * 2u; boff1 = (unsigned)(((R & ~31) | perm32(R & 31)) * K + C) * 2u; }
    const int nM = M / BM, nN = N / BM, nwg = nM * nN, nt = K / BK;
#define TILE_OF(LL, PM, PN) do { int wgid_ = (LL); \
        { const int q_ = nwg / NXCD, r_ = nwg % NXCD, xcd_ = wgid_ % NXCD, off_ = wgid_ / NXCD; wgid_ = (xcd_ < r_ ? xcd_ * (q_ + 1) : r_ * (q_ + 1) + (xcd_ - r_) * q_) + off_; } \
        const int nig_ = WGM * nN, gid_ = wgid_ / nig_, fm_ = gid_ * WGM, gsz_ = (nM - fm_) < WGM ? (nM - fm_) : WGM; \
        PM = fm_ + ((wgid_ % nig_) % gsz_); PN = (wgid_ % nig_) / gsz_; } while (0)
    if constexpr (CONT) {
    if ((int)blockIdx.x < nwg) {
        const int ntile = (nwg - (int)blockIdx.x + (int)gridDim.x - 1) / (int)gridDim.x;
        int pm, pn; TILE_OF((int)blockIdx.x, pm, pn);
        int brow = pm * BM, bcol = pn * BM;
        bf16x8 At[4][2], B0[2][2], B1[2][2];
        STAGE_B(SB(0, 0), bcol, 0); STAGE_A(SA(0, 0), brow, 0); STAGE_B(SB(0, 1), bcol + HALF, 0); STAGE_A(SA(0, 1), brow + HALF, 0);
        if (wr == 1) BAR;
        WAIT_V(4); BAR;
        STAGE_B(SB(1, 0), bcol, 1); STAGE_A(SA(1, 0), brow, 1); STAGE_B(SB(1, 1), bcol + HALF, 1);
        WAIT_V(6); BAR;
#pragma unroll 1
        for (int it = 0; it < ntile; ++it) {
            f32x4 acc[2][2][4][2];
#pragma unroll
            for (int a = 0; a < 2; ++a)
#pragma unroll
                for (int b = 0; b < 2; ++b)
#pragma unroll
                    for (int m = 0; m < 4; ++m)
#pragma unroll
                        for (int n = 0; n < 2; ++n) acc[a][b][m][n] = (f32x4){0.f, 0.f, 0.f, 0.f};
            const bool last_tile = (it + 1 == ntile);
            int pmn = pm, pnn = pn;
            if (!last_tile) TILE_OF((int)blockIdx.x + (it + 1) * (int)gridDim.x, pmn, pnn);
            const int brown = pmn * BM, bcoln = pnn * BM;
            const int tend = last_tile ? nt - 2 : nt;
#pragma unroll 1
            for (int t = 0; t < tend; t += 2) {
                {
                    const bool sw = (t + 2 >= nt);
                    const int br2 = sw ? brown : brow, bc2 = sw ? bcoln : bcol, t2 = sw ? 0 : t + 2;
                    LDB(B0, 0, 0); SCHED; LDA(At, 0, 0); STAGE_A(SA(1, 1), brow + HALF, t + 1);
                    WAIT_L(8); BAR; WAIT_L(0); MMA(0, 0, At, B0); BAR; SCHED;
                    LDB(B1, 0, 1); STAGE_B(SB(0, 0), bc2, t2);
                    BAR; WAIT_L(0); MMA(0, 1, At, B1); BAR;
                    LDA(At, 0, 1); STAGE_A(SA(0, 0), br2, t2);
                    BAR; WAIT_L(0); MMA(1, 0, At, B0); BAR; SCHED;
                    STAGE_B(SB(0, 1), bc2 + HALF, t2);
                    WAIT_V(6); BAR; MMA(1, 1, At, B1); BAR;
                    LDB(B0, 1, 0); SCHED; LDA(At, 1, 0); STAGE_A(SA(0, 1), br2 + HALF, t2);
                    WAIT_L(8); BAR; WAIT_L(0); MMA(0, 0, At, B0); BAR; SCHED;
                    LDB(B1, 1, 1); STAGE_B(SB(1, 0), bc2, t2 + 1);
                    BAR; WAIT_L(0); MMA(0, 1, At, B1); BAR;
                    LDA(At, 1, 1); STAGE_A(SA(1, 0), br2, t2 + 1);
                    BAR; WAIT_L(0); MMA(1, 0, At, B0); BAR; SCHED;
                    STAGE_B(SB(1, 1), bc2 + HALF, t2 + 1);
                    WAIT_V(6); BAR; MMA(1, 1, At, B1); BAR;
                }
            }
            if (last_tile) {
                {
                    { LDB(B0, 0, 0); LDA(At, 0, 0); STAGE_A(SA(1, 1), brow + HALF, nt - 1);
                      BAR; WAIT_L(0); MMA(0, 0, At, B0); BAR;
                      LDB(B1, 0, 1); BAR; WAIT_L(0); MMA(0, 1, At, B1); BAR;
                      LDA(At, 0, 1); WAIT_V(4); BAR; WAIT_L(0); MMA(1, 0, At, B0); MMA(1, 1, At, B1); BAR; }
                    { LDB(B0, 1, 0); LDA(At, 1, 0); WAIT_V(2); BAR; WAIT_L(0); MMA(0, 0, At, B0); BAR;
                      LDB(B1, 1, 1); WAIT_V(0); BAR; WAIT_L(0); MMA(0, 1, At, B1); BAR;
                      LDA(At, 1, 1); BAR; WAIT_L(0); MMA(1, 0, At, B0); MMA(1, 1, At, B1); BAR; }
                }
            }
            gemm_epilogue<EPI, LD>(acc, pm, pn, wid, e);
            pm = pmn; pn = pnn; brow = brown; bcol = bcoln;
        }
        if (wr == 0) BAR;
    }
    } else {
    if ((int)blockIdx.x < nwg) { int pm0_, pn0_; TILE_OF((int)blockIdx.x, pm0_, pn0_); const int brow = pm0_ * BM, bcol = pn0_ * BM;
        STAGE_B(SB(0, 0), bcol, 0); STAGE_A(SA(0, 0), brow, 0); STAGE_B(SB(0, 1), bcol + HALF, 0); STAGE_A(SA(0, 1), brow + HALF, 0); }
    for (int L = blockIdx.x; L < nwg; L += gridDim.x) {
        int pm, pn; TILE_OF(L, pm, pn);
        const int brow = pm * BM, bcol = pn * BM;
        f32x4 acc[2][2][4][2];
#pragma unroll
        for (int a = 0; a < 2; ++a)
#pragma unroll
            for (int b = 0; b < 2; ++b)
#pragma unroll
                for (int m = 0; m < 4; ++m)
#pragma unroll
                    for (int n = 0; n < 2; ++n) acc[a][b][m][n] = (f32x4){0.f, 0.f, 0.f, 0.f};
        bf16x8 At[4][2], B0[2][2], B1[2][2];
        if (wr == 1) BAR;
        WAIT_V(4); BAR;
        STAGE_B(SB(1, 0), bcol, 1); STAGE_A(SA(1, 0), brow, 1); STAGE_B(SB(1, 1), bcol + HALF, 1);
        WAIT_V(6); BAR;
        for (int t = 0; t < nt - 2; t += 2) {
            LDB(B0, 0, 0); SCHED; LDA(At, 0, 0); STAGE_A(SA(1, 1), brow + HALF, t + 1);
            WAIT_L(8); BAR; WAIT_L(0); MMA(0, 0, At, B0); BAR; SCHED;
            LDB(B1, 0, 1); STAGE_B(SB(0, 0), bcol, t + 2);
            BAR; WAIT_L(0); MMA(0, 1, At, B1); BAR;
            LDA(At, 0, 1); STAGE_A(SA(0, 0), brow, t + 2);
            BAR; WAIT_L(0); MMA(1, 0, At, B0); BAR; SCHED;
            STAGE_B(SB(0, 1), bcol + HALF, t + 2);
            WAIT_V(6); BAR; MMA(1, 1, At, B1); BAR;
            LDB(B0, 1, 0); SCHED; LDA(At, 1, 0); STAGE_A(SA(0, 1), brow + HALF, t + 2);
            WAIT_L(8); BAR; WAIT_L(0); MMA(0, 0, At, B0); BAR; SCHED;
            LDB(B1, 1, 1); STAGE_B(SB(1, 0), bcol, t + 3);
            BAR; WAIT_L(0); MMA(0, 1, At, B1); BAR;
            LDA(At, 1, 1); STAGE_A(SA(1, 0), brow, t + 3);
            BAR; WAIT_L(0); MMA(1, 0, At, B0); BAR; SCHED;
            STAGE_B(SB(1, 1), bcol + HALF, t + 3);
            WAIT_V(6); BAR; MMA(1, 1, At, B1); BAR;
        }
        { LDB(B0, 0, 0); LDA(At, 0, 0); STAGE_A(SA(1, 1), brow + HALF, nt - 1);
          BAR; WAIT_L(0); MMA(0, 0, At, B0); BAR;
          LDB(B1, 0, 1); BAR; WAIT_L(0); MMA(0, 1, At, B1); BAR;
          LDA(At, 0, 1); WAIT_V(4); BAR; WAIT_L(0); MMA(1, 0, At, B0); MMA(1, 1, At, B1); BAR; }
        { LDB(B0, 1, 0); LDA(At, 1, 0); WAIT_V(2); BAR; WAIT_L(0); MMA(0, 0, At, B0); BAR;
          LDB(B1, 1, 1); WAIT_V(0); BAR; WAIT_L(0); MMA(0, 1, At, B1); BAR;
          LDA(At, 1, 1); BAR; WAIT_L(0); MMA(1, 0, At, B0); MMA(1, 1, At, B1); BAR; }
        if (wr == 0) BAR;
        { const int Ln = L + (int)gridDim.x;
          if (Ln < nwg) { int pmn, pnn; TILE_OF(Ln, pmn, pnn); const int brn = pmn * BM, bcn = pnn * BM;
              STAGE_B(SB(0, 0), bcn, 0); STAGE_A(SA(0, 0), brn, 0); STAGE_B(SB(0, 1), bcn + HALF, 0); STAGE_A(SA(0, 1), brn + HALF, 0); } }
        gemm_epilogue<EPI, LD>(acc, pm, pn, wid, e);
    }
    }
#undef TILE_OF
#undef SA
#undef SB
#undef STAGE_A
#undef STAGE_B
#undef LDA
#undef LDB
#undef MMA
}

#define KSWZ(row, colB) ((row) * 256 + ((colB) ^ (((row) & 15) << 4)))
#define KSWZ64(row, colB) ((row) * 128 + ((colB) ^ ((((row) >> 1) & 7) << 4)))
#define SBAR() __builtin_amdgcn_sched_barrier(0)
__device__ __forceinline__ int crow(int r, int hi) { return (r & 3) + 8 * (r >> 2) + 4 * hi; }
__device__ __forceinline__ int v_st(int k, int c) { const int kk = (k & ~0xC) | ((k & 4) << 1) | ((k & 8) >> 1); return ((kk >> 3) * 2 + (c >> 5)) * 512 + ((kk & 7) * 32 + (c & 31)) * 2; }
__device__ __forceinline__ int v_rd_base(int lane) { return ((lane & 3) << 3) | (((lane >> 2) & 3) << 6) | (((lane >> 4) & 1) << 5) | (((lane >> 5) & 1) << 8); }
constexpr int v_rd_off(int d0, int ks, int half) { return ((ks * 2 + half) * 2 + d0) * 512; }
template <int OFF> __device__ __forceinline__ s16x4 tr_read(int vb) {
    s16x4 r; asm volatile("ds_read_b64_tr_b16 %0, %1 offset:%2" : "=&v"(r) : "v"(vb), "i"(OFF) : "memory"); return r;
}
template <int D0> __device__ __forceinline__ void pv_one(f32x16& od, int vb, bf16x8 pa0, bf16x8 pa1, bf16x8 pa2, bf16x8 pa3) {
    const s16x4 l0 = tr_read<v_rd_off(D0, 0, 0)>(vb), h0 = tr_read<v_rd_off(D0, 0, 1)>(vb), l1 = tr_read<v_rd_off(D0, 1, 0)>(vb), h1 = tr_read<v_rd_off(D0, 1, 1)>(vb);
    const s16x4 l2 = tr_read<v_rd_off(D0, 2, 0)>(vb), h2 = tr_read<v_rd_off(D0, 2, 1)>(vb), l3 = tr_read<v_rd_off(D0, 3, 0)>(vb), h3 = tr_read<v_rd_off(D0, 3, 1)>(vb);
    asm volatile("s_waitcnt lgkmcnt(0)" ::: "memory"); SBAR();
#define PK(L, H) (bf16x8){L[0], L[1], L[2], L[3], H[0], H[1], H[2], H[3]}
    od = __builtin_amdgcn_mfma_f32_32x32x16_bf16(pa0, PK(l0, h0), od, 0, 0, 0);
    od = __builtin_amdgcn_mfma_f32_32x32x16_bf16(pa1, PK(l1, h1), od, 0, 0, 0);
    od = __builtin_amdgcn_mfma_f32_32x32x16_bf16(pa2, PK(l2, h2), od, 0, 0, 0);
    od = __builtin_amdgcn_mfma_f32_32x32x16_bf16(pa3, PK(l3, h3), od, 0, 0, 0);
#undef PK
}
__device__ __forceinline__ void pv2(f32x16* o, int vb, bf16x8 pa0, bf16x8 pa1, bf16x8 pa2, bf16x8 pa3) {
    pv_one<0>(o[0], vb, pa0, pa1, pa2, pa3); pv_one<1>(o[1], vb, pa0, pa1, pa2, pa3);
}
#define PK4(P, BASE, OUT) do { unsigned a0 = cvtpk(P[BASE + 0], P[BASE + 1]), a1 = cvtpk(P[BASE + 2], P[BASE + 3]);   \
    unsigned b0 = cvtpk(P[BASE + 4], P[BASE + 5]), b1 = cvtpk(P[BASE + 6], P[BASE + 7]);                              \
    auto r0 = __builtin_amdgcn_permlane32_swap(a0, b0, false, false); auto r1 = __builtin_amdgcn_permlane32_swap(a1, b1, false, false); \
    u32x4 w_ = {r0[0], r1[0], r0[1], r1[1]}; OUT = *reinterpret_cast<bf16x8*>(&w_); } while (0)

constexpr float MLA_SCALE = 0.10206207261596577f;
constexpr float MLA_THR = 8.f;
constexpr int SHM_V = 64 * 64 * 2, SHM_K = 64 * 256;

__device__ __forceinline__ void mla_partialSM(f32x16& p0, f32x16& p1, float& m_reg, float& mn, float& alpha) {
    constexpr float C = MLA_SCALE * LOG2E;
    float pmax = p0[0];
#pragma unroll
    for (int r = 1; r < 16; ++r) pmax = fmaxf(pmax, p0[r]);
#pragma unroll
    for (int r = 0; r < 16; ++r) pmax = fmaxf(pmax, p1[r]);
    { auto rr = __builtin_amdgcn_permlane32_swap(__float_as_uint(pmax), __float_as_uint(pmax), false, false);
      pmax = fmaxf(__uint_as_float(rr[0]), __uint_as_float(rr[1])); }
    if (__builtin_expect(__all(pmax - m_reg <= MLA_THR / MLA_SCALE), 1)) { mn = m_reg; alpha = 1.f; }
    else { mn = fmaxf(m_reg, pmax); alpha = __builtin_amdgcn_exp2f((m_reg - mn) * C); m_reg = mn; }
    const float mnC = -mn * C;
#pragma unroll
    for (int r = 0; r < 16; ++r) p0[r] = fmaf(p0[r], C, mnC);
#pragma unroll
    for (int r = 0; r < 16; ++r) p1[r] = fmaf(p1[r], C, mnC);
#pragma unroll
    for (int r = 0; r < 16; ++r) p0[r] = __builtin_amdgcn_exp2f(p0[r]);
}
__device__ __forceinline__ void mla_finishSM(f32x16& p0, f32x16& p1, float alpha, float& l_reg, bf16x8& pa0, bf16x8& pa1, bf16x8& pa2, bf16x8& pa3) {
#pragma unroll
    for (int r = 0; r < 16; ++r) p1[r] = __builtin_amdgcn_exp2f(p1[r]);
    float ps = 0;
#pragma unroll
    for (int r = 0; r < 16; ++r) ps += p0[r];
#pragma unroll
    for (int r = 0; r < 16; ++r) ps += p1[r];
    { auto rr = __builtin_amdgcn_permlane32_swap(__float_as_uint(ps), __float_as_uint(ps), false, false);
      ps = __uint_as_float(rr[0]) + __uint_as_float(rr[1]); }
    l_reg = l_reg * alpha + ps;
    PK4(p0, 0, pa0); PK4(p0, 8, pa1); PK4(p1, 0, pa2); PK4(p1, 8, pa3);
}
constexpr float MLA_THR2 = 8.f;
template <bool FIRST>
__device__ __forceinline__ void mla_partialSM2(f32x16& p0, f32x16& p1, f32x16& negm, float& alpha) {
    float pmax = p0[0];
#pragma unroll
    for (int r = 1; r < 16; ++r) pmax = fmaxf(pmax, p0[r]);
#pragma unroll
    for (int r = 0; r < 16; ++r) pmax = fmaxf(pmax, p1[r]);
    { auto rr = __builtin_amdgcn_permlane32_swap(__float_as_uint(pmax), __float_as_uint(pmax), false, false);
      pmax = fmaxf(__uint_as_float(rr[0]), __uint_as_float(rr[1])); }
    alpha = 1.f;
    if (FIRST || !__builtin_expect(__all(pmax <= MLA_THR2), 1)) {
        const float delta = FIRST ? pmax : fmaxf(pmax, 0.f);
        if (!FIRST) alpha = __builtin_amdgcn_exp2f(-delta);
        const float nm = negm[0] - delta;
#pragma unroll
        for (int r = 0; r < 16; ++r) { p0[r] -= delta; p1[r] -= delta; negm[r] = nm; }
    }
#pragma unroll
    for (int r = 0; r < 16; ++r) p0[r] = __builtin_amdgcn_exp2f(p0[r]);
}
__device__ __forceinline__ void mla_qkt2(f32x16& p0, f32x16& p1, const f32x16& negm, const char* Ks, const bf16x8* qr, int r32, int hi) {
    p0 = negm; p1 = negm;
#pragma unroll
    for (int d0 = 0; d0 < 6; ++d0) { const int cb = (d0 * 16 + hi * 8) * 2;
        const bf16x8 b0 = *reinterpret_cast<const bf16x8*>(Ks + KSWZ(r32, cb));
        const bf16x8 b1 = *reinterpret_cast<const bf16x8*>(Ks + KSWZ(32 + r32, cb));
        p0 = __builtin_amdgcn_mfma_f32_32x32x16_bf16(b0, qr[d0], p0, 0, 0, 0);
        p1 = __builtin_amdgcn_mfma_f32_32x32x16_bf16(b1, qr[d0], p1, 0, 0, 0); }
}
__device__ __forceinline__ void mla_qkt(f32x16& p0, f32x16& p1, const char* Ks, const bf16x8* qr, int r32, int hi) {
    p0 = f32x16{}; p1 = f32x16{};
#pragma unroll
    for (int d0 = 0; d0 < 6; ++d0) { const int cb = (d0 * 16 + hi * 8) * 2;
        const bf16x8 b0 = *reinterpret_cast<const bf16x8*>(Ks + KSWZ(r32, cb));
        const bf16x8 b1 = *reinterpret_cast<const bf16x8*>(Ks + KSWZ(32 + r32, cb));
        p0 = __builtin_amdgcn_mfma_f32_32x32x16_bf16(b0, qr[d0], p0, 0, 0, 0);
        p1 = __builtin_amdgcn_mfma_f32_32x32x16_bf16(b1, qr[d0], p1, 0, 0, 0); }
}

__device__ __forceinline__ void mla_unit(const bf16_t* __restrict__ Qb, const bf16_t* __restrict__ Kh, const bf16_t* __restrict__ Rh, bf16_t* __restrict__ Ob, int seq, int qpos0, const float* __restrict__ cosT, const float* __restrict__ sinT, char* lds, int p_tid) {
    const int tid = p_tid, wid = tid >> 6, lane = tid & 63, r32 = lane & 31, hi = lane >> 5;
    char* V_lds = lds; char* K_lds = lds + 3 * SHM_V;
    float* wsf = (float*)(lds + 3 * SHM_V + 3 * SHM_K) + wid * 64; float* li_l = wsf; float* al_l = wsf + 32;
    bf16_t* stg = (bf16_t*)(lds + 3 * SHM_V + 3 * SHM_K + 2048) + wid * 2048;
    float l_reg = 0; f32x16 o[2] = {}; f32x16 negm = {}; bf16x8 qr[6];
    const bf16_t* Qw = Qb + (size_t)(wid * 32 + r32) * 768 + hi * 8;
#pragma unroll
    for (int d0 = 0; d0 < 6; ++d0) qr[d0] = *reinterpret_cast<const bf16x8*>(Qw + d0 * 16);
    {
        const int sq = qpos0 + wid * 32 + r32;
        const f32x4 c0 = *(const f32x4*)(cosT + sq * 16 + hi * 8), c1 = *(const f32x4*)(cosT + sq * 16 + hi * 8 + 4);
        const f32x4 s0 = *(const f32x4*)(sinT + sq * 16 + hi * 8), s1 = *(const f32x4*)(sinT + sq * 16 + hi * 8 + 4);
        float a[8], b[8];
#pragma unroll
        for (int j = 0; j < 8; ++j) { const float x1 = bf2f((unsigned short)qr[4][j]), x2 = bf2f((unsigned short)qr[5][j]);
            const float c = j < 4 ? c0[j & 3] : c1[j & 3], s = j < 4 ? s0[j & 3] : s1[j & 3];
            a[j] = x1 * c - x2 * s; b[j] = x1 * s + x2 * c; }
        u32x4 wa = {cvtpk(a[0], a[1]), cvtpk(a[2], a[3]), cvtpk(a[4], a[5]), cvtpk(a[6], a[7])};
        u32x4 wb = {cvtpk(b[0], b[1]), cvtpk(b[2], b[3]), cvtpk(b[4], b[5]), cvtpk(b[6], b[7])};
        qr[4] = *reinterpret_cast<bf16x8*>(&wa); qr[5] = *reinterpret_cast<bf16x8*>(&wb);
    }
    const int skey = tid >> 3, sc = (tid & 7) * 8;
    const int rkey = (tid & 255) >> 2, rc = (tid & 3) * 8;
    const int vst = v_st(skey, sc), kst = KSWZ(skey, sc * 2), rst = KSWZ(rkey, (64 + rc) * 2);
    const int vb0 = (int)(uintptr_t)V_lds + v_rd_base(lane);
    struct { bf16x8 v, k, r; } sr_[1];
#define SLOAD(i, k0) do { const bf16_t* kp_ = Kh + (size_t)((k0) + skey) * 1024 + sc; sr_[i].v = *reinterpret_cast<const bf16x8*>(kp_ + 64); \
        sr_[i].k = *reinterpret_cast<const bf16x8*>(kp_); sr_[i].r = *reinterpret_cast<const bf16x8*>(Rh + (size_t)((k0) + rkey) * 32 + rc); } while (0)
#define SWRITE(b, i) do { *(bf16x8*)(V_lds + (b) * SHM_V + vst) = sr_[i].v; *(bf16x8*)(K_lds + (b) * SHM_K + kst) = sr_[i].k; \
        *(bf16x8*)(K_lds + (b) * SHM_K + rst) = sr_[i].r; } while (0)
#define SWAIT() asm volatile("s_waitcnt vmcnt(0)" ::: "memory")
#define RESC(a) do { if (__any((a) < 1.f)) { if (hi == 0) al_l[r32] = (a); asm volatile("s_waitcnt lgkmcnt(0)" ::: "memory"); \
        _Pragma("unroll") for (int d = 0; d < 2; ++d) _Pragma("unroll") for (int r = 0; r < 16; ++r) o[d][r] *= al_l[crow(r, hi)]; } } while (0)
    f32x16 pA0, pA1, pB0, pB1; float alA, alB; bf16x8 pa0, pa1, pa2, pa3; const int NT = seq / 64;
    SLOAD(0, 0);
    SWAIT(); SWRITE(0, 0); SLOAD(0, 64);
    __syncthreads();
    SWAIT(); SWRITE(1, 0); SLOAD(0, 128);
    mla_qkt2(pA0, pA1, negm, K_lds, qr, r32, hi); mla_partialSM2<true>(pA0, pA1, negm, alA);
    int sp = 0, sc_ = 1, sn = 2;
    for (int j = 1; j + 1 < NT; j += 2) {
        __syncthreads();
        SBAR(); mla_qkt2(pB0, pB1, negm, K_lds + sc_ * SHM_K, qr, r32, hi);
        mla_finishSM(pA0, pA1, alA, l_reg, pa0, pa1, pa2, pa3); SBAR();
        SWAIT(); SWRITE(sn, 0); if (j + 2 < NT) SLOAD(0, (j + 2) * 64);
        SBAR(); pv_one<0>(o[0], vb0 + sp * SHM_V, pa0, pa1, pa2, pa3);
        pv_one<1>(o[1], vb0 + sp * SHM_V, pa0, pa1, pa2, pa3);
        mla_partialSM2<false>(pB0, pB1, negm, alB);
        RESC(alB);
        { const int t_ = sp; sp = sc_; sc_ = sn; sn = t_; }
        __syncthreads();
        SBAR(); mla_qkt2(pA0, pA1, negm, K_lds + sc_ * SHM_K, qr, r32, hi);
        mla_finishSM(pB0, pB1, alB, l_reg, pa0, pa1, pa2, pa3); SBAR();
        SWAIT(); SWRITE(sn, 0); if (j + 3 < NT) SLOAD(0, (j + 3) * 64);
        SBAR(); pv_one<0>(o[0], vb0 + sp * SHM_V, pa0, pa1, pa2, pa3);
        pv_one<1>(o[1], vb0 + sp * SHM_V, pa0, pa1, pa2, pa3);
        mla_partialSM2<false>(pA0, pA1, negm, alA);
        RESC(alA);
        { const int t_ = sp; sp = sc_; sc_ = sn; sn = t_; }
    }
    __syncthreads();
    SBAR(); mla_qkt2(pB0, pB1, negm, K_lds + sc_ * SHM_K, qr, r32, hi);
    mla_finishSM(pA0, pA1, alA, l_reg, pa0, pa1, pa2, pa3); SBAR();
    pv2(o, vb0 + sp * SHM_V, pa0, pa1, pa2, pa3); mla_partialSM2<false>(pB0, pB1, negm, alB);
    RESC(alB);
    mla_finishSM(pB0, pB1, alB, l_reg, pa0, pa1, pa2, pa3); SBAR();
    pv2(o, vb0 + sc_ * SHM_V, pa0, pa1, pa2, pa3);
    if (hi == 0) li_l[r32] = l_reg; asm volatile("s_waitcnt lgkmcnt(0)" ::: "memory");
    float rli[16];
#pragma unroll
    for (int r = 0; r < 16; ++r) rli[r] = __builtin_amdgcn_rcpf(li_l[crow(r, hi)]);
#pragma unroll
    for (int r = 0; r < 16; r += 1) { const int orow = crow(r, hi);
#pragma unroll
        for (int d0 = 0; d0 < 2; ++d0) stg[orow * 64 + d0 * 32 + r32] = (bf16_t)(cvtpk(o[d0][r] * rli[r], 0.f) & 0xffffu); }
    asm volatile("s_waitcnt lgkmcnt(0)" ::: "memory");
    bf16_t* Ow = Ob + (size_t)(wid * 32) * 1024;
#pragma unroll
    for (int i = 0; i < 4; ++i) { const int row = i * 8 + (lane >> 3), ch = lane & 7; const u32x4 v = *(const u32x4*)(stg + row * 64 + ch * 8); *(u32x4*)(Ow + (size_t)row * 1024 + ch * 8) = v; }
    __syncthreads();
#undef SLOAD
#undef SWRITE
#undef SWAIT
}

__device__ __forceinline__ void mla_phase(const Params& p, char* lds, int p_tid) {
    const bf16_t* Q = (const bf16_t*)(p.ws + WS_U + U_Q); const bf16_t* KV = (const bf16_t*)(p.ws + WS_U + U_KV); const bf16_t* KR = (const bf16_t*)(p.ws + WS_U + U_KR);
    bf16_t* H = (bf16_t*)(p.ws + WS_H);
    for (int u = blockIdx.x; u < 1536; u += gridDim.x) {
        int tok0, qb, h, seq;
        if (u < 1024) { const int i = u >> 8, c = u & 255, bh = i * 8 + (c & 7); qb = c >> 3; h = bh & 7; tok0 = (bh >> 3) * 8192; seq = 8192; }
        else { const int u2 = u - 1024, i = u2 >> 8, c = u2 & 255, bh = (i * 8 + (c & 7)) * 4 + (c >> 6); qb = (c >> 3) & 7; h = bh & 7; tok0 = MPROMPT + (bh >> 3) * 2048; seq = 2048; }
        const int q0 = tok0 + qb * 256;
        mla_unit(Q + (size_t)q0 * 768 + h * 96, KV + (size_t)tok0 * 1024 + h * 128, KR + (size_t)tok0 * 32, H + (size_t)q0 * 1024 + h * 64, seq, qb * 256, (const float*)(p.ws + WS_COS), (const float*)(p.ws + WS_SIN), lds, p_tid);
    }
}

__device__ __forceinline__ void dil_qkt(f32x16& p0, f32x16& p1, const char* Ks, const bf16x8* qr, int r32, int hi) {
    p0 = f32x16{}; p1 = f32x16{};
#pragma unroll
    for (int d0 = 0; d0 < 4; ++d0) { const int cb = (d0 * 16 + hi * 8) * 2;
        const bf16x8 b0 = *reinterpret_cast<const bf16x8*>(Ks + KSWZ64(r32, cb));
        const bf16x8 b1 = *reinterpret_cast<const bf16x8*>(Ks + KSWZ64(32 + r32, cb));
        p0 = __builtin_amdgcn_mfma_f32_32x32x16_bf16(b0, qr[d0], p0, 0, 0, 0);
        p1 = __builtin_amdgcn_mfma_f32_32x32x16_bf16(b1, qr[d0], p1, 0, 0, 0); }
}
struct DilU { int tokbase, L, d, rr, h, br, I0; };
__device__ __forceinline__ DilU dil_decode(int u) {
    int seg, b, br, rr, qb, hd;
    if (u < 3072) { seg = 0; const int bh = u / 96; b = bh >> 3; hd = bh & 7; const int rem = u % 96; br = rem >> 5; const int x = rem & 31;
        if (br == 0) { rr = 0; qb = x; } else if (br == 1) { rr = x & 3; qb = x >> 2; } else { rr = x & 15; qb = x >> 4; } }
    else { seg = 1; const int u2 = u - 3072; const int bh = u2 >> 5; b = bh >> 3; hd = bh & 7; const int rem = u2 & 31;
        if (rem < 8) { br = 0; rr = 0; qb = rem; } else if (rem < 16) { br = 1; rr = (rem - 8) & 3; qb = (rem - 8) >> 2; } else { br = 2; rr = rem - 16; qb = 0; } }
    DilU r; r.h = hd; r.br = br; r.rr = rr; r.I0 = qb * 256;
    r.tokbase = seg ? MPROMPT + b * 2048 : b * 8192;
    r.d = br == 0 ? 1 : (br == 1 ? 4 : 16); r.L = (seg ? 2048 : 8192) / r.d;
    return r;
}
__device__ __forceinline__ void dil_phase(const Params& p, char* lds, int p_tid) {
    const bf16_t* ZD = (const bf16_t*)(p.ws + WS_U + U_ZD);
    const int tid = p_tid, wid = tid >> 6, lane = tid & 63, r32 = lane & 31, hi = lane >> 5;
    char* K_lds = lds; char* V_lds = lds + 6 * 8192;
    float* wsf = (float*)(lds + 12 * 8192) + wid * 64; float* li_l = wsf; float* al_l = wsf + 32;
    bf16_t* stg = (bf16_t*)(lds + 12 * 8192 + 2048) + wid * 2048;
    const int skey = tid >> 3, sc = (tid & 7) * 8;
    const int kst = KSWZ64(skey, sc * 2), vst = v_st(skey, sc);
    const int vb0 = (int)(uintptr_t)V_lds + v_rd_base(lane);
#define DIL_LOAD(U) bf16x8 kreg[6], vreg[6], qreg[4]; do { const int KB_ = (U).I0 - 64; \
        _Pragma("unroll") for (int T = 0; T < 6; ++T) { int kf = KB_ + 64 * T + skey; kf = kf < 0 ? 0 : (kf > (U).L - 1 ? (U).L - 1 : kf); \
            const size_t ro = (size_t)((U).tokbase + kf * (U).d + (U).rr) * 64 + sc; \
            kreg[T] = *reinterpret_cast<const bf16x8*>(ZD + (size_t)(8 + (U).h) * MTOK * 64 + ro); vreg[T] = *reinterpret_cast<const bf16x8*>(ZD + (size_t)(16 + (U).h) * MTOK * 64 + ro); } \
        { int qfc = (U).I0 + wid * 32 + r32; qfc = qfc > (U).L - 1 ? (U).L - 1 : qfc; \
          const bf16_t* qp = ZD + (size_t)(U).h * MTOK * 64 + (size_t)((U).tokbase + qfc * (U).d + (U).rr) * 64 + hi * 8; \
          _Pragma("unroll") for (int d0 = 0; d0 < 4; ++d0) qreg[d0] = *reinterpret_cast<const bf16x8*>(qp + d0 * 16); } } while (0)
    for (int u = blockIdx.x; u < 5120; u += gridDim.x) {
        const DilU cur = dil_decode(u);
        bf16x8 qr[4];
        { DIL_LOAD(cur);
#pragma unroll
          for (int T = 0; T < 6; ++T) { *(bf16x8*)(K_lds + T * 8192 + kst) = kreg[T]; *(bf16x8*)(V_lds + T * 8192 + vst) = vreg[T]; }
#pragma unroll
          for (int d0 = 0; d0 < 4; ++d0) qr[d0] = qreg[d0]; }
        __syncthreads();
        const int L = cur.L, d = cur.d, I0 = cur.I0, KB = I0 - 64, h = cur.h, rr = cur.rr, tokbase = cur.tokbase;
        bf16_t* OB = (bf16_t*)(p.ws + WS_U + U_OB) + (size_t)cur.br * MTOK * 512;
        f32x2* ML = (f32x2*)(p.ws + WS_U + U_ML) + (size_t)cur.br * MTOK * 8;
        const int qf = I0 + wid * 32 + r32;
        const bool wv = (I0 + wid * 32) < L;
        const bool edge = (KB < 0) || (KB + 384 > L);
        float m_reg = -1e30f, l_reg = 0.f; f32x16 o[2] = {};
        if (wv) {
            const float nsl = -__builtin_amdgcn_exp2f(-(float)(h + 1)) * (float)d * LOG2E;
            const float kh = (float)(4 * hi);
            const int T0 = wid >> 1;
            f32x16 P[3][2];
#pragma unroll
            for (int tt = 0; tt < 3; ++tt) { P[tt][0] = f32x16{}; P[tt][1] = f32x16{}; }
#pragma unroll
            for (int d0 = 0; d0 < 4; ++d0) { const int cb = (d0 * 16 + hi * 8) * 2;
#pragma unroll
                for (int tt = 0; tt < 3; ++tt) { const char* Ks = K_lds + (T0 + tt) * 8192;
                    const bf16x8 b0 = *reinterpret_cast<const bf16x8*>(Ks + KSWZ64(r32, cb)), b1 = *reinterpret_cast<const bf16x8*>(Ks + KSWZ64(32 + r32, cb));
                    P[tt][0] = __builtin_amdgcn_mfma_f32_32x32x16_bf16(b0, qr[d0], P[tt][0], 0, 0, 0);
                    P[tt][1] = __builtin_amdgcn_mfma_f32_32x32x16_bf16(b1, qr[d0], P[tt][1], 0, 0, 0); } }
            float pm0 = -3.0e38f, pm1 = -3.0e38f;
#pragma unroll
            for (int tt = 0; tt < 3; ++tt) {
                const int kbase = KB + 64 * (T0 + tt);
                const float rbh = (float)(kbase - qf) + kh;
                if (!edge) {
#pragma unroll
                    for (int r = 0; r < 16; ++r) {
                        const float c_r = (float)((r & 3) + 8 * (r >> 2));
                        const float a0 = __builtin_fabsf(rbh + c_r), a1 = __builtin_fabsf(rbh + (c_r + 32.f));
                        const float s0 = fmaf(a0, nsl, P[tt][0][r]), s1 = fmaf(a1, nsl, P[tt][1][r]);
                        P[tt][0][r] = (a0 <= 64.f) ? s0 : -1e30f; P[tt][1][r] = (a1 <= 64.f) ? s1 : -1e30f;
                        pm0 = fmaxf(pm0, P[tt][0][r]); pm1 = fmaxf(pm1, P[tt][1][r]);
                    }
                } else {
                    const float klo = (float)(-kbase) - kh, khi_ = (float)(L - kbase) - kh;
#pragma unroll
                    for (int r = 0; r < 16; ++r) {
                        const float c_r = (float)((r & 3) + 8 * (r >> 2));
                        const float a0 = __builtin_fabsf(rbh + c_r), a1 = __builtin_fabsf(rbh + (c_r + 32.f));
                        const float s0 = fmaf(a0, nsl, P[tt][0][r]), s1 = fmaf(a1, nsl, P[tt][1][r]);
                        P[tt][0][r] = ((a0 <= 64.f) && (c_r >= klo) && (c_r < khi_)) ? s0 : -1e30f;
                        P[tt][1][r] = ((a1 <= 64.f) && (c_r + 32.f >= klo) && (c_r + 32.f < khi_)) ? s1 : -1e30f;
                        pm0 = fmaxf(pm0, P[tt][0][r]); pm1 = fmaxf(pm1, P[tt][1][r]);
                    }
                }
            }
            float pmax = fmaxf(pm0, pm1);
            { auto rr2 = __builtin_amdgcn_permlane32_swap(__float_as_uint(pmax), __float_as_uint(pmax), false, false);
              pmax = fmaxf(__uint_as_float(rr2[0]), __uint_as_float(rr2[1])); }
            m_reg = pmax;
            float ps0 = 0.f, ps1 = 0.f;
#pragma unroll
            for (int tt = 0; tt < 3; ++tt)
#pragma unroll
                for (int r = 0; r < 16; ++r) { P[tt][0][r] = __builtin_amdgcn_exp2f(P[tt][0][r] - pmax); P[tt][1][r] = __builtin_amdgcn_exp2f(P[tt][1][r] - pmax); ps0 += P[tt][0][r]; ps1 += P[tt][1][r]; }
            float ps = ps0 + ps1;
            { auto rr2 = __builtin_amdgcn_permlane32_swap(__float_as_uint(ps), __float_as_uint(ps), false, false);
              ps = __uint_as_float(rr2[0]) + __uint_as_float(rr2[1]); }
            l_reg = ps;
#pragma unroll
            for (int tt = 0; tt < 3; ++tt) {
                bf16x8 pa0, pa1, pa2, pa3;
                PK4(P[tt][0], 0, pa0); PK4(P[tt][0], 8, pa1); PK4(P[tt][1], 0, pa2); PK4(P[tt][1], 8, pa3);
                pv2(o, vb0 + (T0 + tt) * 8192, pa0, pa1, pa2, pa3);
            }
        }
        if (wv) {
            if (hi == 0) { li_l[r32] = l_reg; ML[(size_t)(tokbase + qf * d + rr) * 8 + h] = (f32x2){m_reg, l_reg}; }
            asm volatile("s_waitcnt lgkmcnt(0)" ::: "memory");
            float rli[16];
#pragma unroll
            for (int r = 0; r < 16; ++r) rli[r] = __builtin_amdgcn_rcpf(li_l[crow(r, hi)]);
#pragma unroll
            for (int r = 0; r < 16; ++r) { const int orow = crow(r, hi);
#pragma unroll
                for (int d0 = 0; d0 < 2; ++d0) stg[orow * 64 + d0 * 32 + r32] = (bf16_t)(cvtpk(o[d0][r] * rli[r], 0.f) & 0xffffu); }
            asm volatile("s_waitcnt lgkmcnt(0)" ::: "memory");
#pragma unroll
            for (int i = 0; i < 4; ++i) { const int row = i * 8 + (lane >> 3), ch = lane & 7; const u32x4 v = *(const u32x4*)(stg + row * 64 + ch * 8);
                const int qrow = I0 + wid * 32 + row;
                *(u32x4*)(OB + (size_t)(tokbase + qrow * d + rr) * 512 + h * 64 + ch * 8) = v; }
        }
        __syncthreads();
    }
#undef DIL_LOAD
}
#undef RESC


template <int L>
__device__ __forceinline__ void layer_phase(const Params& p, int s, char* lds, int wave) {
    const int p_tid = phase_tid(wave);
    unsigned char* ws = p.ws;
    bf16_t* H = (bf16_t*)(ws + WS_H); bf16_t* U = (bf16_t*)(ws + WS_U);
    EpiArgs e{}; e.cosT = (const float*)(ws + WS_COS); e.sinT = (const float*)(ws + WS_SIN);
    if (s == 0) {
        e.o0 = (bf16_t*)(ws + WS_U + U_LAT); e.o1 = (bf16_t*)(ws + WS_U + U_ZD);
        gemm_phase<EPI_Z, 2048, 1024, 0>(H, (const bf16_t*)(ws + WS_WIN), e, lds, p_tid);
    } else if (s == 1) {
        latent_pass(p, L, p_tid);
        dil_phase(p, lds, p_tid);
    } else if (s == 2) {
        e.o0 = (bf16_t*)(ws + WS_U + U_Q);
        gemm_phase<EPI_QSCALE, 768, 256, 768>((const bf16_t*)(ws + WS_U + U_LQN), (const bf16_t*)(ws + WS_WUQ), e, lds, p_tid);
        __syncthreads();
        e.o0 = (bf16_t*)(ws + WS_U + U_KV);
        gemm_phase<EPI_PLAIN, 1024, 128, 1024, false>((const bf16_t*)(ws + WS_U + U_LKVN), (const bf16_t*)(ws + WS_WUKV), e, lds, phase_tid(wave));
    } else if (s == 3) {
        mla_phase(p, lds, p_tid);
    } else if (s == 4) {
        combine_pass(p, L, p_tid);
    } else if (s == 5) {
        e.o0 = (bf16_t*)(ws + WS_U + U_MIX);
        gemm_phase<EPI_PLAIN, 1024, 1024, 1024>(H, (const bf16_t*)(ws + WS_WOUT), e, lds, p_tid);
    } else if (s == 6) {
        rowpass(p, L == 0, (const bf16_t*)(ws + WS_U + U_MIX), p.in[11] + L * 1024, p.in[12] + L * 1024, H, p_tid, false);
    } else if (s == 7) {
        e.o0 = U;
        gemm_phase<EPI_RELU2, 4096, 1024, 4096>(H, (const bf16_t*)(ws + WS_WUP), e, lds, p_tid);
    } else if (s == 8) {
        e.o0 = H;
        gemm_phase<EPI_PLAIN, 1024, 4096, 1024>(U, (const bf16_t*)(ws + WS_WDN), e, lds, p_tid);
    } else {
        if (L + 1 < DEPTH) convert_weights(p, L + 1, lds, p_tid);
        rowpass(p, false, H, p.in[15] + L * 1024, (L + 1 < DEPTH) ? p.in[2] + (L + 1) * 1024 : nullptr, H, p_tid, L + 1 == DEPTH);
    }
}

__device__ __forceinline__ void grid_barrier(unsigned* cnt, unsigned target, int p_tid) {
    asm volatile("s_waitcnt vmcnt(0) lgkmcnt(0)" ::: "memory");
    __syncthreads();
    if ((p_tid >> 6) == 0) {
        __builtin_amdgcn_fence(__ATOMIC_RELEASE, "agent");
        asm volatile("s_waitcnt vmcnt(0)" ::: "memory");
        if (p_tid == 0) {
            __hip_atomic_fetch_add(cnt, 1u, __ATOMIC_RELAXED, __HIP_MEMORY_SCOPE_AGENT);
            while (__hip_atomic_load(cnt, __ATOMIC_RELAXED, __HIP_MEMORY_SCOPE_AGENT) < target) __builtin_amdgcn_s_sleep(1);
        }
        __builtin_amdgcn_fence(__ATOMIC_ACQUIRE, "agent");
        asm volatile("s_waitcnt vmcnt(0)" ::: "memory");
    }
    __syncthreads();
}

constexpr int PH_PER_LAYER = 10;
constexpr int NPHASE = 1 + PH_PER_LAYER * DEPTH;

__global__ void __launch_bounds__(NTHREADS) fwd_megakernel(Params p) {
    extern __shared__ __attribute__((aligned(16))) char shm[];
    const int lo = p.ph_lo, hi = p.ph_hi;
    const int wave = __builtin_amdgcn_readfirstlane((int)(threadIdx.x >> 6));
    unsigned* bar_cnt = (unsigned*)(p.ws + WS_BAR);
    if (hi - lo > 1) {
        if (blockIdx.x == 0 && threadIdx.x == 0) __hip_atomic_store(bar_cnt, 0u, __ATOMIC_RELAXED, __HIP_MEMORY_SCOPE_AGENT);
        cg::this_grid().sync();
    }
    const unsigned nblk = gridDim.x;
#ifndef DUP_MASK
#define DUP_MASK 0
#endif
#define PHASE(k, body) if (lo <= (k) && (k) < hi) { body; if ((DUP_MASK >> (k)) & 1) { __syncthreads(); body; } if ((k) + 1 < hi) grid_barrier(bar_cnt, (unsigned)((k) - lo + 1) * nblk, phase_tid(wave)); }
    PHASE(0, { const int p_tid = phase_tid(wave); convert_weights(p, 0, shm, p_tid); rope_table(p, p_tid); rowpass(p, true, nullptr, nullptr, p.in[2], (bf16_t*)(p.ws + WS_H), p_tid, false); })
    PHASE(1, layer_phase<0>(p, 0, shm, wave))
    PHASE(2, layer_phase<0>(p, 1, shm, wave))
    PHASE(3, layer_phase<0>(p, 2, shm, wave))
    PHASE(4, layer_phase<0>(p, 3, shm, wave))
    PHASE(5, layer_phase<0>(p, 4, shm, wave))
    PHASE(6, layer_phase<0>(p, 5, shm, wave))
    PHASE(7, layer_phase<0>(p, 6, shm, wave))
    PHASE(8, layer_phase<0>(p, 7, shm, wave))
    PHASE(9, layer_phase<0>(p, 8, shm, wave))
    PHASE(10, layer_phase<0>(p, 9, shm, wave))
    PHASE(11, layer_phase<1>(p, 0, shm, wave))
    PHASE(12, layer_phase<1>(p, 1, shm, wave))
    PHASE(13, layer_phase<1>(p, 2, shm, wave))
    PHASE(14, layer_phase<1>(p, 3, shm, wave))
    PHASE(15, layer_phase<1>(p, 4, shm, wave))
    PHASE(16, layer_phase<1>(p, 5, shm, wave))
    PHASE(17, layer_phase<1>(p, 6, shm, wave))
    PHASE(18, layer_phase<1>(p, 7, shm, wave))
    PHASE(19, layer_phase<1>(p, 8, shm, wave))
    PHASE(20, layer_phase<1>(p, 9, shm, wave))
#undef PHASE
}

extern "C" void kernel_launch(void* const* d_in, const int* in_sizes, int n_in, void* d_out, int out_size, void* d_ws, size_t ws_size, hipStream_t stream) {
    static int grid_blocks = 0;
    if (grid_blocks == 0) {
        if (n_in != 16 || out_size != MTOK * DM || ws_size < WS_END) {
            fprintf(stderr, "kernel_launch: shape/workspace mismatch: n_in %d out %d ws %zu (need %zu)\n", n_in, out_size, ws_size, (size_t)WS_END);
            grid_blocks = -1; return;
        }
        int dev = 0, cus = 0, per_cu = 0;
        hipGetDevice(&dev);
        hipDeviceGetAttribute(&cus, hipDeviceAttributeMultiprocessorCount, dev);
        if (hipFuncSetAttribute((const void*)fwd_megakernel, hipFuncAttributeMaxDynamicSharedMemorySize, LDS_BYTES) != hipSuccess) {
            fprintf(stderr, "kernel_launch: hipFuncSetAttribute failed\n"); grid_blocks = -1; return;
        }
        hipOccupancyMaxActiveBlocksPerMultiprocessor(&per_cu, (const void*)fwd_megakernel, NTHREADS, LDS_BYTES);
        if (per_cu < 1) per_cu = 1;
        if (per_cu > 1) per_cu = 1;
        grid_blocks = cus * per_cu;
        (void)hipGetLastError();
    }
    if (grid_blocks < 0) return;
    Params p{};
    for (int i = 0; i < 16; ++i) p.in[i] = (const float*)d_in[i];
    p.out = (float*)d_out; p.ws = (unsigned char*)d_ws;
#if MK_MULTI
    for (int ph = 0; ph < NPHASE; ++ph) {
        p.ph_lo = ph; p.ph_hi = ph + 1;
        hipLaunchKernelGGL(fwd_megakernel, dim3(grid_blocks), dim3(NTHREADS), LDS_BYTES, stream, p);
    }
#else
    p.ph_lo = 0; p.ph_hi = NPHASE;
    void* args[] = {&p};
    hipError_t e = hipLaunchCooperativeKernel((const void*)fwd_megakernel, dim3(grid_blocks), dim3(NTHREADS), args, LDS_BYTES, stream);
    if (e != hipSuccess) fprintf(stderr, "cooperative launch failed: %s (grid %d)\n", hipGetErrorString(e), grid_blocks);
#endif
}
```
